# Optimizing an MI355X kernel written in HIP

```python
import math
import jax, jax.numpy as jnp
from jax import lax
import numpy as np

D_MODEL = 1024
BATCH = 8
SEQ = 2048
DEPTH = 2
DEC_BATCH = 128
DEC_SEQ = 8
PAST_LEN = 16384
PAGE_SIZE = 128

N_MIXERS = 2
N_A_LAYERS = (DEPTH + 1) // 2
N_B_LAYERS = DEPTH // 2
CHUNK = 128
D_GMLP = 3 * D_MODEL
G_A = 8
GW_A = D_GMLP // G_A
D_RNN = D_MODEL
H_B = 8
BW_B = D_RNN // H_B
CONV_W = 4
LRU_C = 8.0
D_FF = ((8 * D_MODEL + 3 * 256 - 1) // (3 * 256)) * 256
EPS = 1e-6

kernel_name = "hybrid_gmlp_rglru_decode_step"


def rms_norm(x, g):
    xf = x.astype(jnp.float32)
    y = xf * lax.rsqrt(jnp.mean(xf * xf, axis=-1, keepdims=True) + EPS)
    return (y * g.astype(jnp.float32)).astype(x.dtype)


def layer_norm(x, g, b):
    xf = x.astype(jnp.float32)
    mu = jnp.mean(xf, axis=-1, keepdims=True)
    xc = xf - mu
    y = xc * lax.rsqrt(jnp.mean(xc * xc, axis=-1, keepdims=True) + EPS)
    return (y * g.astype(jnp.float32) + b.astype(jnp.float32)).astype(x.dtype)


def gmlp_mixer(h, w_in, b_in, ln_g, ln_b, w_s, b_s, w_out):
    B, T, _ = h.shape
    z = jax.nn.gelu(h @ w_in + b_in)
    u, v = jnp.split(z, 2, axis=-1)
    v = layer_norm(v, ln_g, ln_b)
    n_chunks = -(-T // CHUNK)
    pad = n_chunks * CHUNK - T
    vp = jnp.pad(v, ((0, 0), (0, pad), (0, 0))).reshape(B, n_chunks, CHUNK, G_A, GW_A)
    mask = jnp.tril(jnp.ones((CHUNK, CHUNK), dtype=bool))
    ws = jnp.where(mask[None], w_s, jnp.zeros_like(w_s))
    mixed = jnp.einsum('gts,bcsge->bctge', ws, vp) + jnp.transpose(b_s)[None, None, :, :, None]
    mixed = mixed.reshape(B, n_chunks * CHUNK, D_GMLP)[:, :T]
    return (u * mixed) @ w_out, v


def _lin_comb(left, right):
    a_l, b_l = left
    a_r, b_r = right
    return a_l * a_r, a_r * b_l + b_r


def rglru_mixer(h, conv_hist, h0, w_in, conv_w, conv_b, w_a, b_a, w_x, b_x, lam, w_out):
    B, T, _ = h.shape
    y_br, x_br = jnp.split(h @ w_in, 2, axis=-1)
    gate = jax.nn.gelu(y_br)
    xpad = jnp.concatenate([conv_hist.astype(x_br.dtype), x_br], axis=1)
    xc = conv_b + sum(conv_w[k] * xpad[:, k:k + T] for k in range(CONV_W))
    new_hist = xpad[:, T:]
    xb = xc.reshape(B, T, H_B, BW_B)
    r = jax.nn.sigmoid(jnp.einsum('bthi,hij->bthj', xb, w_a) + b_a).reshape(B, T, D_RNN)
    i = jax.nn.sigmoid(jnp.einsum('bthi,hij->bthj', xb, w_x) + b_x).reshape(B, T, D_RNN)
    log_a = -LRU_C * r.astype(jnp.float32) * jax.nn.softplus(-lam.astype(jnp.float32))
    a = jnp.exp(log_a)
    mult = jnp.sqrt(-jnp.expm1(2.0 * log_a))
    b = mult * (i * xc).astype(jnp.float32)
    b = b.at[:, 0].add(a[:, 0] * h0.astype(jnp.float32))
    _, hs = lax.associative_scan(_lin_comb, (a, b), axis=1)
    out = (hs.astype(h.dtype) * gate) @ w_out
    return out, new_hist, hs[:, -1].astype(h.dtype)


def swiglu(h, w_in, w_out):
    g, u = jnp.split(h @ w_in, 2, axis=-1)
    return (jax.nn.silu(g) * u) @ w_out


def trunk(x, conv_hist, h0, norm_gains,
          gm_w_in, gm_b_in, gm_ln_g, gm_ln_b, gm_w_s, gm_b_s, gm_w_out,
          rg_w_in, rg_conv_w, rg_conv_b, rg_w_a, rg_b_a, rg_w_x, rg_b_x, rg_lambda, rg_w_out,
          ffn_w_in, ffn_w_out):
    new_conv, new_h, v_rows = [], [], []
    for li in range(DEPTH):
        g = norm_gains[li]
        hn = rms_norm(x, g[0])
        j = li // N_MIXERS
        if li % N_MIXERS == 0:
            m, v = gmlp_mixer(hn, gm_w_in[j], gm_b_in[j], gm_ln_g[j], gm_ln_b[j],
                              gm_w_s[j], gm_b_s[j], gm_w_out[j])
            v_rows.append(v)
        else:
            m, hist, hl = rglru_mixer(hn, conv_hist[j], h0[j], rg_w_in[j], rg_conv_w[j], rg_conv_b[j],
                                      rg_w_a[j], rg_b_a[j], rg_w_x[j], rg_b_x[j], rg_lambda[j], rg_w_out[j])
            new_conv.append(hist)
            new_h.append(hl)
        x = x + rms_norm(m, g[1])
        f = swiglu(rms_norm(x, g[2]), ffn_w_in[li], ffn_w_out[li])
        x = x + rms_norm(f, g[3])
    return x, jnp.stack(new_conv), jnp.stack(new_h), jnp.stack(v_rows)


def setup_inputs(seed: int = 0) -> dict:
    key = jax.random.key(seed)
    ks = jax.random.split(key, 24)
    f32 = jnp.float32
    nrm = lambda k, shape, scale: jax.random.normal(k, shape, f32) * scale
    u = jax.random.uniform(ks[20], (N_B_LAYERS, D_RNN), f32, 0.9, 0.999)
    s = u ** (1.0 / LRU_C)
    return {
        "x_prompt": nrm(ks[0], (BATCH, SEQ, D_MODEL), 1.0),
        "x_sample": nrm(ks[1], (DEC_BATCH, DEC_SEQ, D_MODEL), 1.0),
        "state_conv": nrm(ks[2], (N_B_LAYERS, DEC_BATCH, CONV_W - 1, D_RNN), 1.0),
        "state_h": nrm(ks[3], (N_B_LAYERS, DEC_BATCH, D_RNN), 1.0),
        "norm_gains": 1.0 + nrm(ks[4], (DEPTH, 4, D_MODEL), 0.02),
        "gm_w_in": nrm(ks[5], (N_A_LAYERS, D_MODEL, 2 * D_GMLP), D_MODEL ** -0.5),
        "gm_b_in": nrm(ks[6], (N_A_LAYERS, 2 * D_GMLP), 0.02),
        "gm_ln_g": 1.0 + nrm(ks[7], (N_A_LAYERS, D_GMLP), 0.02),
        "gm_ln_b": nrm(ks[8], (N_A_LAYERS, D_GMLP), 0.02),
        "gm_w_s": nrm(ks[9], (N_A_LAYERS, G_A, CHUNK, CHUNK), CHUNK ** -0.5),
        "gm_b_s": 1.0 + nrm(ks[10], (N_A_LAYERS, G_A, CHUNK), 0.02),
        "gm_w_out": nrm(ks[11], (N_A_LAYERS, D_GMLP, D_MODEL), D_GMLP ** -0.5),
        "rg_w_in": nrm(ks[12], (N_B_LAYERS, D_MODEL, 2 * D_RNN), D_MODEL ** -0.5),
        "rg_conv_w": nrm(ks[13], (N_B_LAYERS, CONV_W, D_RNN), CONV_W ** -0.5),
        "rg_conv_b": nrm(ks[14], (N_B_LAYERS, D_RNN), 0.02),
        "rg_w_a": nrm(ks[15], (N_B_LAYERS, H_B, BW_B, BW_B), BW_B ** -0.5),
        "rg_b_a": nrm(ks[16], (N_B_LAYERS, H_B, BW_B), 0.02),
        "rg_w_x": nrm(ks[17], (N_B_LAYERS, H_B, BW_B, BW_B), BW_B ** -0.5),
        "rg_b_x": nrm(ks[18], (N_B_LAYERS, H_B, BW_B), 0.02),
        "rg_lambda": jnp.log(s) - jnp.log1p(-s),
        "rg_w_out": nrm(ks[19], (N_B_LAYERS, D_RNN, D_MODEL), D_RNN ** -0.5),
        "ffn_w_in": nrm(ks[21], (DEPTH, D_MODEL, 2 * D_FF), D_MODEL ** -0.5),
        "ffn_w_out": nrm(ks[22], (DEPTH, D_FF, D_MODEL), D_FF ** -0.5),
    }


def reference(x_prompt, x_sample, state_conv, state_h, norm_gains,
              gm_w_in, gm_b_in, gm_ln_g, gm_ln_b, gm_w_s, gm_b_s, gm_w_out,
              rg_w_in, rg_conv_w, rg_conv_b, rg_w_a, rg_b_a, rg_w_x, rg_b_x, rg_lambda, rg_w_out,
              ffn_w_in, ffn_w_out):
    weights = (norm_gains, gm_w_in, gm_b_in, gm_ln_g, gm_ln_b, gm_w_s, gm_b_s, gm_w_out,
               rg_w_in, rg_conv_w, rg_conv_b, rg_w_a, rg_b_a, rg_w_x, rg_b_x, rg_lambda, rg_w_out,
               ffn_w_in, ffn_w_out)
    zero_conv = jnp.zeros((N_B_LAYERS, x_prompt.shape[0], CONV_W - 1, D_RNN), x_prompt.dtype)
    zero_h = jnp.zeros((N_B_LAYERS, x_prompt.shape[0], D_RNN), x_prompt.dtype)
    y_prompt, p_conv, p_h, _ = trunk(x_prompt, zero_conv, zero_h, *weights)
    y_sample, s_conv, s_h, s_v = trunk(x_sample, state_conv, state_h, *weights)
    return (y_prompt, y_sample, p_conv, p_h, s_conv, s_h, s_v)
```

```cpp
#include <hip/hip_runtime.h>
#include <hip/hip_cooperative_groups.h>
#include <cstdio>
#include <cstdint>
#include <cmath>
namespace cg = cooperative_groups;

#ifndef MK_ONE_LAUNCH
#define MK_ONE_LAUNCH 1
#endif

#define LAS __attribute__((address_space(3)))
typedef unsigned short bf16_t;
typedef short bf16x8 __attribute__((ext_vector_type(8)));
typedef float f32x4 __attribute__((ext_vector_type(4)));
typedef float f32x2 __attribute__((ext_vector_type(2)));
typedef unsigned u32x4 __attribute__((ext_vector_type(4)));
typedef unsigned u32x2 __attribute__((ext_vector_type(2)));

constexpr int D = 1024, MTP = 16384, MTS = 1024, MT = MTP + MTS, DG = 3072, DFF = 2816, SEQ = 2048;
constexpr float EPS = 1e-6f;
constexpr int NWAVES = 8, NTHR = 512;
constexpr int LDS_BYTES = 147456;
constexpr size_t O_Y = 0, O_PCONV = (size_t)MT * D, O_PH = O_PCONV + 8 * 3 * 1024, O_SCONV = O_PH + 8 * 1024, O_SH = O_SCONV + 128 * 3 * 1024, O_SV = O_SH + 128 * 1024;
constexpr size_t MiB = 1u << 20;
constexpr size_t WS_SP = 0;
constexpr size_t WS_BAR = 65536;
constexpr size_t WS_CNT = 262144;
constexpr size_t CNT_WORDS = (4 * 2 * 64 + 4 * 4) * 64;
constexpr size_t WS_FLG = WS_CNT + CNT_WORDS * 4;
constexpr size_t CTL_ZERO_BYTES = WS_FLG + 272 * 8 * 64 - WS_BAR;
static_assert(WS_FLG + 272 * 8 * 64 <= 1u << 20, "control region");
constexpr size_t WS_RSTD = 131072;
constexpr size_t WS_ST = 1 * MiB;
constexpr size_t WS_WG3 = 5 * MiB;
constexpr size_t WS_WF1 = 11 * MiB;
constexpr size_t WS_WF2 = 22 * MiB;
constexpr size_t WS_WF1B = WS_WF2 + 5632 * 1024;
constexpr size_t WS_WF2B = WS_WF1B + 11 * MiB;
constexpr size_t WS_WR1 = 44 * MiB;
constexpr size_t WS_WR2 = 48 * MiB;
constexpr size_t WS_WAX = 50 * MiB;
constexpr size_t WS_WSB = WS_WAX + 512 * 1024;
constexpr size_t WS_TS = WS_ST;
constexpr size_t WS_U = 52 * MiB;
constexpr size_t WS_V = 154 * MiB;
constexpr size_t DO_HN = 0, DO_WG1 = 36 * MiB;
static_assert((size_t)MT * D * 2 <= DO_WG1 && DO_WG1 + (size_t)6144 * 1024 * 2 <= (size_t)MT * D * 4, "d_out scratch");
static_assert(WS_TS + (size_t)272 * 1024 * 8 <= WS_WG3 && WS_WSB + 8 * 128 * 128 * 2 <= WS_U, "ts");
static_assert(WS_U + (size_t)MT * DG * 2 <= WS_V, "U region");
static_assert(WS_V + (size_t)MT * DG * 2 <= 256 * MiB, "V region");
static_assert(WS_ST + (size_t)24 * MT * 8 <= WS_WG3, "stats");

namespace pg8 {
constexpr int BM = 256, BK = 64, HALF = 128, HTB = HALF * BK * 2, STAGE_BYTES = 8 * HTB, NXCD = 8, WGM = 8;
__host__ __device__ __forceinline__ int lds_byte(int r, int c) { const int st = (r >> 4) * 2 + (c >> 5), rr = r & 15, cc = c & 31, ob = rr * 64 + cc * 2; return st * 1024 + (ob ^ (((ob >> 9) & 1) << 5)); }
__host__ __device__ __forceinline__ void stage_rc(int b, int& R, int& C) { const int st = b / 1024, sb = b % 1024, swz = sb ^ (((sb >> 9) & 1) << 5); R = (st >> 1) * 16 + swz / 64; C = (st & 1) * 32 + (swz % 64) / 2; }
__host__ __device__ __forceinline__ int perm32(int rho) { const int n = rho >> 4, i = rho & 15; return 8 * (i >> 2) + 4 * n + (i & 3); }

struct Unit { const char* a; const char* b; int pm, pn, kind, nt, ks; };
struct Sched {
    const char *A0, *B0, *A1, *B1; int nM0, nN0, nM1, nN1, n0, nwg, G, c, ntF; size_t tstep;
    __device__ __forceinline__ void init(const void* a0, const void* b0, int M0, int N0, const void* a1, const void* b1, int M1, int N1, int K, int G_, int c_) {
        A0 = (const char*)a0; B0 = (const char*)b0; A1 = (const char*)a1; B1 = (const char*)b1; nM0 = M0 / BM; nN0 = N0 / BM; nM1 = M1 / BM; nN1 = N1 / BM;
        n0 = nM0 * nN0; nwg = n0 + nM1 * nN1; G = G_; c = c_; ntF = K / BK; tstep = (size_t)BM * K * 2; }
    __device__ __forceinline__ bool next(int i, Unit& u) const {
        const long L = (long)i * G + c; if (L >= nwg) return false;
        int wgid = (int)L; { const int q = nwg / NXCD, r = nwg % NXCD, xcd = wgid % NXCD, off = wgid / NXCD; wgid = (xcd < r ? xcd * (q + 1) : r * (q + 1) + (xcd - r) * q) + off; }
        int kind = 0, nM = nM0, nN = nN0; const char* A = A0; const char* B = B0;
        if (wgid >= n0) { wgid -= n0; kind = 1; nM = nM1; nN = nN1; A = A1; B = B1; }
        const int nig = WGM * nN, gid = wgid / nig, fm = gid * WGM, gsz = (nM - fm) < WGM ? (nM - fm) : WGM;
        u.pm = fm + ((wgid % nig) % gsz); u.pn = (wgid % nig) / gsz; u.kind = kind; u.nt = ntF; u.ks = 0; u.a = A + (size_t)u.pm * tstep; u.b = B + (size_t)u.pn * tstep; return true;
    }
};
struct SchedTail {
    const char *A, *B; int G, c, ntF, NS; size_t tstep;
    __device__ __forceinline__ void init(const void* a, const void* b, int K, int NS_, int G_, int c_) { A = (const char*)a; B = (const char*)b; G = G_; c = c_; ntF = K / BK; NS = NS_; tstep = (size_t)BM * K * 2; }
    __device__ __forceinline__ bool next(int i, Unit& u) const {
        const int L = i * G + c;
        if (L < 256) { u.pm = 8 * (L & 7) + ((L >> 3) & 7); u.pn = L >> 6; u.kind = 0; u.nt = ntF; u.ks = 0; u.a = A + (size_t)u.pm * tstep; u.b = B + (size_t)u.pn * tstep; return true; }
        const int r = L - 256; if (r >= 16 * NS) return false;
        const int ks = r % NS, t = r / NS, hp = ntF >> 1, p0 = ks * hp / NS, p1 = (ks + 1) * hp / NS;
        u.pm = 64 + (t >> 2); u.pn = t & 3; u.kind = 1; u.ks = ks; u.nt = 2 * (p1 - p0);
        u.a = A + (size_t)u.pm * tstep + (size_t)p0 * (4 * BK); u.b = B + (size_t)u.pn * tstep + (size_t)p0 * (4 * BK); return true;
    }
};

__device__ __forceinline__ unsigned cvt_pk_bf16(float lo, float hi) { unsigned r; asm volatile("v_cvt_pk_bf16_f32 %0, %1, %2" : "=v"(r) : "v"(lo), "v"(hi)); return r; }
__device__ __forceinline__ float gelu_t(float x) {
    const float y = x * (1.0f + 0.044715f * x * x) * (-1.5957691216f * 1.4426950409f);
    return x * __builtin_amdgcn_rcpf(1.0f + __builtin_amdgcn_exp2f(y));
}
__device__ __forceinline__ float sigmoid_f(float x) { return __builtin_amdgcn_rcpf(1.0f + __builtin_amdgcn_exp2f(x * -1.4426950409f)); }
__device__ __forceinline__ f32x2 gelu2(f32x2 x) {
    const f32x2 t = (x * x) * (0.044715f * -1.5957691216f * 1.4426950409f) + (-1.5957691216f * 1.4426950409f), y = x * t;
    f32x2 e; e.x = __builtin_amdgcn_exp2f(y.x); e.y = __builtin_amdgcn_exp2f(y.y);
    const f32x2 d = e + 1.0f; f32x2 r; r.x = __builtin_amdgcn_rcpf(d.x); r.y = __builtin_amdgcn_rcpf(d.y);
    return x * r;
}
__device__ __forceinline__ f32x2 silu_mul2(f32x2 g, f32x2 u) {
    const f32x2 y = g * -1.4426950409f; f32x2 e; e.x = __builtin_amdgcn_exp2f(y.x); e.y = __builtin_amdgcn_exp2f(y.y);
    const f32x2 d = e + 1.0f; f32x2 r; r.x = __builtin_amdgcn_rcpf(d.x); r.y = __builtin_amdgcn_rcpf(d.y);
    return (g * r) * u;
}
__device__ __forceinline__ float rstd16(const float* p4) {
    const f32x4 t = *(const f32x4*)p4; return __builtin_amdgcn_rsqf(((t[0] + t[1]) + (t[2] + t[3])) * (1.f / D) + EPS); }
__device__ __forceinline__ f32x4 gelu4s(f32x4 v) { return (f32x4){gelu_t(v[0]), gelu_t(v[1]), gelu_t(v[2]), gelu_t(v[3])}; }
__device__ __forceinline__ f32x4 gelu4(f32x4 v) { const f32x2 a = gelu2((f32x2){v[0], v[1]}), b = gelu2((f32x2){v[2], v[3]}); return (f32x4){a.x, a.y, b.x, b.y}; }

template <int ACT> __device__ __forceinline__ void store_tile_bf16(const f32x4 (&acc)[2][2][4][2], int pm, int coltile, bf16_t* O, int ldc, const float* bias  , int wr, int wc, int fr, int fq, const float* rs = nullptr  , bool rs16 = false  ) {
    const int row0 = pm * BM + wr * 64 + fr, col0 = coltile + wc * 32 + 8 * fq;
    f32x4 bv[2][2];
#pragma unroll
    for (int bj = 0; bj < 2; ++bj)
#pragma unroll
        for (int n = 0; n < 2; ++n) bv[bj][n] = bias ? *(const f32x4*)(bias + wc * 32 + 8 * fq + bj * HALF + 4 * n) : (f32x4){0.f, 0.f, 0.f, 0.f};
#pragma unroll
    for (int ai = 0; ai < 2; ++ai)
#pragma unroll
        for (int m = 0; m < 4; ++m) { bf16_t* rowp = O + (size_t)(row0 + ai * HALF + m * 16) * ldc + col0; const float rsv = rs ? (rs16 ? rstd16(rs + (size_t)(row0 + ai * HALF + m * 16) * 4) : rs[row0 + ai * HALF + m * 16]) : 1.0f;
#pragma unroll
            for (int bj = 0; bj < 2; ++bj) { f32x4 v0 = acc[ai][bj][m][0] * rsv + bv[bj][0], v1 = acc[ai][bj][m][1] * rsv + bv[bj][1];
                if (ACT == 1) { v0 = gelu4s(v0); v1 = gelu4s(v1); }
                if (ACT == 2) { v0 = gelu4(v0); v1 = gelu4(v1); }
                u32x4 w; w.x = cvt_pk_bf16(v0[0], v0[1]); w.y = cvt_pk_bf16(v0[2], v0[3]); w.z = cvt_pk_bf16(v1[0], v1[1]); w.w = cvt_pk_bf16(v1[2], v1[3]);
                *(u32x4*)(rowp + bj * HALF) = w; } }
}

struct EpiPlain {
    bf16_t* O; int ldc;
    __device__ __forceinline__ void operator()(const f32x4 (&acc)[2][2][4][2], const Unit& u, int wr, int wc, int fr, int fq) const { store_tile_bf16<0>(acc, u.pm, u.pn * BM, O, ldc, nullptr, wr, wc, fr, fq); }
};
struct EpiTail {
    bf16_t* O; float* PB;
    __device__ __forceinline__ void operator()(const f32x4 (&acc)[2][2][4][2], const Unit& u, int wr, int wc, int fr, int fq) const {
        if (u.kind == 0) { store_tile_bf16<0>(acc, u.pm, u.pn * BM, O, D, nullptr, wr, wc, fr, fq); return; }
        float* base = PB + (size_t)u.ks * (MTS * D) + (size_t)((u.pm - 64) * BM + wr * 64 + fr) * D + u.pn * BM + wc * 32 + 8 * fq;
#pragma unroll
        for (int ai = 0; ai < 2; ++ai)
#pragma unroll
            for (int m = 0; m < 4; ++m)
#pragma unroll
                for (int bj = 0; bj < 2; ++bj) { float* p = base + (size_t)(ai * HALF + m * 16) * D + bj * HALF; *(f32x4*)p = acc[ai][bj][m][0]; *(f32x4*)(p + 4) = acc[ai][bj][m][1]; }
    }
};
struct RmsExchange {
    float* xbuf; unsigned* cnt;
    __device__ __forceinline__ void publish(const f32x4 (&v)[2][2][4][2], int pm, int pn, int wr, int wc, int fr, int fq, LAS unsigned char* lds) const {
        LAS float* P = (LAS float*)lds;
        const int wid = wr * 4 + wc, lane = fq * 16 + fr;
#pragma unroll
        for (int ai = 0; ai < 2; ++ai)
#pragma unroll
            for (int m = 0; m < 4; ++m) { float s = 0.f;
#pragma unroll
                for (int bj = 0; bj < 2; ++bj)
#pragma unroll
                    for (int n = 0; n < 2; ++n) { const f32x4 x = v[ai][bj][m][n]; s += (x[0] * x[0] + x[1] * x[1]) + (x[2] * x[2] + x[3] * x[3]); }
                s += __shfl_xor(s, 16); s += __shfl_xor(s, 32);
                if (fq == 0) P[(ai * HALF + wr * 64 + m * 16 + fr) * 4 + wc] = s; }
        asm volatile("s_waitcnt lgkmcnt(0)" ::: "memory"); __builtin_amdgcn_s_barrier(); asm volatile("" ::: "memory");
        const int row = wid * 32 + (lane & 31);
        if (lane < 32) { const float t = (P[row * 4 + 0] + P[row * 4 + 1]) + (P[row * 4 + 2] + P[row * 4 + 3]);
            __hip_atomic_store(xbuf + ((size_t)(pm * BM + row) * 4 + pn), t, __ATOMIC_RELAXED, __HIP_MEMORY_SCOPE_AGENT); }
        asm volatile("s_waitcnt vmcnt(0)" ::: "memory");
        if (lane == 0) __hip_atomic_fetch_add(cnt + 64 * pm, 1u, __ATOMIC_RELAXED, __HIP_MEMORY_SCOPE_AGENT);
    }
    __device__ __forceinline__ void wait(int pm, int pn, int wr, int wc, int fr, int fq, LAS unsigned char* lds, float* rstd_out  ) const {
        LAS float* S = (LAS float*)(lds + 4096);
        const int wid = wr * 4 + wc, lane = fq * 16 + fr, row = wid * 32 + (lane & 31);
        if (wid == 0) { unsigned sp = 0;
            while ((unsigned)__builtin_amdgcn_readfirstlane(__hip_atomic_load(cnt + 64 * pm, __ATOMIC_RELAXED, __HIP_MEMORY_SCOPE_AGENT)) < 32u) { __builtin_amdgcn_s_sleep(2); if (++sp > (1u << 22)) break; }
            __builtin_amdgcn_fence(__ATOMIC_ACQUIRE, "agent"); }
        asm volatile("s_waitcnt vmcnt(0) lgkmcnt(0)" ::: "memory"); __builtin_amdgcn_s_barrier(); asm volatile("" ::: "memory");
        if (lane < 32) { const float* slot = xbuf + (size_t)(pm * BM + row) * 4; float t = 0.f;
#pragma unroll
            for (int k = 0; k < 4; ++k) t += __hip_atomic_load(slot + k, __ATOMIC_RELAXED, __HIP_MEMORY_SCOPE_AGENT);
            const float rs = __builtin_amdgcn_rsqf(t * (1.f / D) + EPS); S[row] = rs;
            if (rstd_out && pn == 0) rstd_out[pm * BM + row] = rs; }
        asm volatile("s_waitcnt lgkmcnt(0)" ::: "memory"); __builtin_amdgcn_s_barrier(); asm volatile("" ::: "memory");
    }
};
template <bool FINAL> struct EpiTailFused {
    bf16_t* PB; RmsExchange e1; const bf16_t* XBin  ; bf16_t* XB  ; const float* g1; float* outf; float* RSTD  ; LAS unsigned char* ldsx;
    static __device__ __forceinline__ void unpack8(f32x4& a, f32x4& b, u32x4 w) {
        a = (f32x4){__builtin_bit_cast(float, w.x << 16), __builtin_bit_cast(float, w.x & 0xffff0000u), __builtin_bit_cast(float, w.y << 16), __builtin_bit_cast(float, w.y & 0xffff0000u)};
        b = (f32x4){__builtin_bit_cast(float, w.z << 16), __builtin_bit_cast(float, w.z & 0xffff0000u), __builtin_bit_cast(float, w.w << 16), __builtin_bit_cast(float, w.w & 0xffff0000u)}; }
    __device__ __forceinline__ void operator()(f32x4 (&acc)[2][2][4][2], const Unit& u, int wr, int wc, int fr, int fq) const {
        if (u.kind == 1) {
            bf16_t* base = PB + (size_t)u.ks * (MTS * D) + (size_t)((u.pm - 64) * BM + wr * 64 + fr) * D + u.pn * BM + wc * 32 + 8 * fq;
#pragma unroll
            for (int ai = 0; ai < 2; ++ai)
#pragma unroll
                for (int m = 0; m < 4; ++m)
#pragma unroll
                    for (int bj = 0; bj < 2; ++bj) { const f32x4 v0 = acc[ai][bj][m][0], v1 = acc[ai][bj][m][1]; u32x4 w; w.x = cvt_pk_bf16(v0[0], v0[1]); w.y = cvt_pk_bf16(v0[2], v0[3]); w.z = cvt_pk_bf16(v1[0], v1[1]); w.w = cvt_pk_bf16(v1[2], v1[3]);
                        *(u32x4*)(base + (size_t)(ai * HALF + m * 16) * D + bj * HALF) = w; }
            return; }
        const LAS float* S = (const LAS float*)(ldsx + 4096);
        const int col0 = u.pn * BM + wc * 32 + 8 * fq;
        e1.publish(acc, u.pm, u.pn, wr, wc, fr, fq, ldsx);
        u32x4 pre[4][2];
#pragma unroll
        for (int m = 0; m < 4; ++m)
#pragma unroll
            for (int bj = 0; bj < 2; ++bj) pre[m][bj] = *(const u32x4*)(XBin + (size_t)(u.pm * BM + wr * 64 + m * 16 + fr) * D + col0 + bj * HALF);
        f32x4 gv[2][2];
#pragma unroll
        for (int bj = 0; bj < 2; ++bj)
#pragma unroll
            for (int n = 0; n < 2; ++n) gv[bj][n] = *(const f32x4*)(g1 + col0 + bj * HALF + 4 * n);
        e1.wait(u.pm, u.pn, wr, wc, fr, fq, ldsx, nullptr);
#pragma unroll
        for (int ai = 0; ai < 2; ++ai)
#pragma unroll
            for (int m = 0; m < 4; ++m) { const int row = ai * HALF + wr * 64 + m * 16 + fr; const float rs = S[row]; const size_t off = (size_t)(u.pm * BM + row) * D + col0; float s2 = 0.f;
#pragma unroll
                for (int bj = 0; bj < 2; ++bj) { f32x4 x0, x1; unpack8(x0, x1, ai == 0 ? pre[m][bj] : *(const u32x4*)(XBin + off + bj * HALF));
                    const f32x4 v0 = x0 + acc[ai][bj][m][0] * rs * gv[bj][0], v1 = x1 + acc[ai][bj][m][1] * rs * gv[bj][1];
                    s2 += ((v0[0] * v0[0] + v0[1] * v0[1]) + (v0[2] * v0[2] + v0[3] * v0[3])) + ((v1[0] * v1[0] + v1[1] * v1[1]) + (v1[2] * v1[2] + v1[3] * v1[3]));
                    if (FINAL) { *(f32x4*)(outf + off + bj * HALF) = v0; *(f32x4*)(outf + off + bj * HALF + 4) = v1; }
                    else { u32x4 w; w.x = cvt_pk_bf16(v0[0], v0[1]); w.y = cvt_pk_bf16(v0[2], v0[3]); w.z = cvt_pk_bf16(v1[0], v1[1]); w.w = cvt_pk_bf16(v1[2], v1[3]); *(u32x4*)(XB + off + bj * HALF) = w; } }
                if (!FINAL) { s2 += __shfl_xor(s2, 16); s2 += __shfl_xor(s2, 32);
                    if (fq == 0) ((LAS float*)ldsx)[row * 4 + wc] = s2; }
                if (m == 3) asm volatile("" ::: "memory"); }
        if (!FINAL) {
            asm volatile("s_waitcnt lgkmcnt(0)" ::: "memory"); __builtin_amdgcn_s_barrier(); asm volatile("" ::: "memory");
            const int wid = wr * 4 + wc, lane = fq * 16 + fr, row = wid * 32 + (lane & 31); const LAS float* P = (const LAS float*)ldsx;
            if (lane < 32) RSTD[(size_t)(u.pm * BM + row) * 4 + u.pn] = (P[row * 4 + 0] + P[row * 4 + 1]) + (P[row * 4 + 2] + P[row * 4 + 3]);
            asm volatile("s_waitcnt lgkmcnt(0)" ::: "memory"); __builtin_amdgcn_s_barrier(); asm volatile("" ::: "memory");
        }
    }
};
struct EpiG6 {
    bf16_t* GATE; bf16_t* XBR; const float* rs;
    __device__ __forceinline__ void operator()(const f32x4 (&acc)[2][2][4][2], const Unit& u, int wr, int wc, int fr, int fq) const {
        if (u.pn < 4) store_tile_bf16<2>(acc, u.pm, u.pn * BM, GATE, D, nullptr, wr, wc, fr, fq, rs, true);
        else store_tile_bf16<0>(acc, u.pm, (u.pn - 4) * BM, XBR, D, nullptr, wr, wc, fr, fq, rs, true);
    }
};
struct EpiSwiglu {
    bf16_t* H; const float* rs;
    __device__ __forceinline__ void operator()(const f32x4 (&acc)[2][2][4][2], const Unit& u, int wr, int wc, int fr, int fq) const {
        const int row0 = u.pm * BM + wr * 64 + fr, col0 = u.pn * HALF + wc * 32 + 8 * fq;
#pragma unroll
        for (int ai = 0; ai < 2; ++ai)
#pragma unroll
            for (int m = 0; m < 4; ++m) { bf16_t* rowp = H + (size_t)(row0 + ai * HALF + m * 16) * DFF + col0; f32x4 o[2]; const float rsv = rstd16(rs + (size_t)(row0 + ai * HALF + m * 16) * 4);
#pragma unroll
                for (int n = 0; n < 2; ++n) { const f32x4 g = acc[ai][0][m][n] * rsv, uu = acc[ai][1][m][n] * rsv;
                    const f32x2 a = silu_mul2((f32x2){g[0], g[1]}, (f32x2){uu[0], uu[1]}), b = silu_mul2((f32x2){g[2], g[3]}, (f32x2){uu[2], uu[3]}); o[n] = (f32x4){a.x, a.y, b.x, b.y}; }
                u32x4 w; w.x = cvt_pk_bf16(o[0][0], o[0][1]); w.y = cvt_pk_bf16(o[0][2], o[0][3]); w.z = cvt_pk_bf16(o[1][0], o[1][1]); w.w = cvt_pk_bf16(o[1][2], o[1][3]);
                *(u32x4*)rowp = w; }
    }
};
__device__ __forceinline__ float row16_sum_lane0(float v) {
    v += __builtin_bit_cast(float, __builtin_amdgcn_update_dpp(0, __builtin_bit_cast(int, v), 0x108, 0xf, 0xf, true));
    v += __builtin_bit_cast(float, __builtin_amdgcn_update_dpp(0, __builtin_bit_cast(int, v), 0x104, 0xf, 0xf, true));
    v += __builtin_bit_cast(float, __builtin_amdgcn_update_dpp(0, __builtin_bit_cast(int, v), 0x102, 0xf, 0xf, true));
    v += __builtin_bit_cast(float, __builtin_amdgcn_update_dpp(0, __builtin_bit_cast(int, v), 0x101, 0xf, 0xf, true));
    return v;
}
struct EpiG1 {
    bf16_t* U; bf16_t* VT; const float* b_in; f32x2* ST; const float* rs;
    __device__ __forceinline__ void operator()(const f32x4 (&acc)[2][2][4][2], const Unit& u, int wr, int wc, int fr, int fq) const {
        if (u.kind == 0) { store_tile_bf16<2>(acc, u.pm, u.pn * BM, U, DG, b_in + u.pn * BM, wr, wc, fr, fq, rs); return; }
        const int row0 = u.pm * BM + wr * 64 + fr, col0 = u.pn * BM + wc * 32 + 8 * fq;
#pragma unroll
        for (int bj = 0; bj < 2; ++bj) {
            float cs[2][4], cq[2][4]; const f32x4 rc0 = *(const f32x4*)(rs + col0 + bj * HALF), rc1 = *(const f32x4*)(rs + col0 + bj * HALF + 4);
#pragma unroll
            for (int n = 0; n < 2; ++n)
#pragma unroll
                for (int j = 0; j < 4; ++j) { cs[n][j] = 0.f; cq[n][j] = 0.f; }
#pragma unroll
            for (int ai = 0; ai < 2; ++ai)
#pragma unroll
                for (int m = 0; m < 4; ++m) { const int row = row0 + ai * HALF + m * 16; const float bv = b_in[DG + row]; bf16_t* rowp = VT + (size_t)row * MT + col0 + bj * HALF;
                    { const f32x4 v0 = gelu4s(acc[ai][bj][m][0] * rc0 + bv);
#pragma unroll
                      for (int j = 0; j < 4; ++j) { cs[0][j] += v0[j]; cq[0][j] += v0[j] * v0[j]; }
                      u32x2 w; w.x = cvt_pk_bf16(v0[0], v0[1]); w.y = cvt_pk_bf16(v0[2], v0[3]); *(u32x2*)rowp = w; }
                    { const f32x4 v1 = gelu4s(acc[ai][bj][m][1] * rc1 + bv);
#pragma unroll
                      for (int j = 0; j < 4; ++j) { cs[1][j] += v1[j]; cq[1][j] += v1[j] * v1[j]; }
                      u32x2 w; w.x = cvt_pk_bf16(v1[0], v1[1]); w.y = cvt_pk_bf16(v1[2], v1[3]); *(u32x2*)(rowp + 4) = w; } }
#pragma unroll
            for (int n = 0; n < 2; ++n) {
#pragma unroll
                for (int j = 0; j < 4; ++j) { cs[n][j] = row16_sum_lane0(cs[n][j]); cq[n][j] = row16_sum_lane0(cq[n][j]); }
                if (fr == 0) { f32x2* sp = ST + (size_t)(u.pm * 2 + wr) * MT + col0 + bj * HALF + 4 * n;
                    *(f32x4*)(sp) = (f32x4){cs[n][0], cq[n][0], cs[n][1], cq[n][1]};
                    *(f32x4*)(sp + 2) = (f32x4){cs[n][2], cq[n][2], cs[n][3], cq[n][3]}; } }
            asm volatile("" ::: "memory");
        }
    }
};

template <class Epi, class SchedT>
__device__ __forceinline__ void gemm_phase(LAS unsigned char* lds, const int K, const SchedT& S, const Epi& E) {
    const int tid = threadIdx.x, wid = __builtin_amdgcn_readfirstlane(tid >> 6), lane = tid & 63, wr = wid >> 2, wc = wid & 3, fr = lane & 15, fq = lane >> 4;
    unsigned voffA[2], voffB[2];
#pragma unroll
    for (int i = 0; i < 2; ++i) { int R, C; stage_rc(tid * 16 + i * 8192, R, C); const int Rb = (R & ~31) + perm32(R & 31);
        voffA[i] = (unsigned)(R * K + C) * 2u; voffB[i] = (unsigned)(Rb * K + C) * 2u; }
    const size_t kstep = (size_t)(BK * 2);
    const size_t hstep = (size_t)HALF * K * 2;
    const unsigned ldsw = (unsigned)wid * 1024u;
    const int aoff = lds_byte(wr * 64 + fr, fq * 8), boff = lds_byte(wc * 32 + fr, fq * 8);
#define PG8_SA(b, h) (((b) * 2 + (h)) * HTB)
#define PG8_SB(b, h) ((4 + (b) * 2 + (h)) * HTB)
#define PG8_STAGE(bufoff, gbase, voff) do { _Pragma("unroll") for (int _i = 0; _i < 2; ++_i) \
        __builtin_amdgcn_global_load_lds((const unsigned*)((const char*)(gbase) + (voff)[_i]), (LAS unsigned*)(lds + (bufoff) + ldsw + _i * 8192), 16, 0, 0); } while (0)
#define PG8_LDA(dst, b, h) do { _Pragma("unroll") for (int m = 0; m < 4; ++m) _Pragma("unroll") for (int k = 0; k < 2; ++k) dst[m][k] = *(const LAS bf16x8*)(lds + PG8_SA(b, h) + aoff + m * 2048 + k * 1024); } while (0)
#define PG8_LDB(dst, b, h) do { _Pragma("unroll") for (int n = 0; n < 2; ++n) _Pragma("unroll") for (int k = 0; k < 2; ++k) dst[n][k] = *(const LAS bf16x8*)(lds + PG8_SB(b, h) + boff + n * 2048 + k * 1024); } while (0)
#define PG8_MMA(ai, bj, At, Bt) do { __builtin_amdgcn_s_setprio(1); _Pragma("unroll") for (int m = 0; m < 4; ++m) _Pragma("unroll") for (int n = 0; n < 2; ++n) _Pragma("unroll") for (int k = 0; k < 2; ++k) \
        acc[ai][bj][m][n] = __builtin_amdgcn_mfma_f32_16x16x32_bf16(Bt[n][k], At[m][k], acc[ai][bj][m][n], 0, 0, 0); __builtin_amdgcn_s_setprio(0); } while (0)
#define PG8_WAIT_V(n) asm volatile("s_waitcnt vmcnt(" #n ")" ::: "memory")
#define PG8_WAIT_L(n) asm volatile("s_waitcnt lgkmcnt(" #n ")" ::: "memory")
#define PG8_BAR __builtin_amdgcn_s_barrier()
#define PG8_SCHED __builtin_amdgcn_sched_barrier(0)
    Unit cur, nxt; int ui = 0;
    if (!S.next(0, cur)) return;
    f32x4 acc[2][2][4][2];
#pragma unroll
    for (int a = 0; a < 2; ++a)
#pragma unroll
        for (int b = 0; b < 2; ++b)
#pragma unroll
            for (int m = 0; m < 4; ++m)
#pragma unroll
                for (int n = 0; n < 2; ++n) acc[a][b][m][n] = (f32x4){0.f, 0.f, 0.f, 0.f};
    bf16x8 At[4][2], B0[2][2], B1[2][2];
    const char* cA = cur.a; const char* cB = cur.b;
    PG8_WAIT_V(0);
    PG8_STAGE(PG8_SB(0, 0), cB, voffB); PG8_STAGE(PG8_SB(0, 1), cB + hstep, voffB); PG8_STAGE(PG8_SA(0, 0), cA, voffA); PG8_STAGE(PG8_SA(0, 1), cA + hstep, voffA);
    if (wr == 1) PG8_BAR;
    PG8_WAIT_V(2); PG8_BAR;
    PG8_STAGE(PG8_SB(1, 0), cB + kstep, voffB); PG8_STAGE(PG8_SA(1, 0), cA + kstep, voffA); PG8_STAGE(PG8_SB(1, 1), cB + hstep + kstep, voffB);
    PG8_WAIT_V(6); PG8_BAR;
    for (;;) {
        const bool has_next = S.next(ui + 1, nxt); const int nt = cur.nt;
        const char* nA = has_next ? nxt.a : cA; const char* nB = has_next ? nxt.b : cB;
        for (int t = 0; t < nt; t += 2) {
            const bool last = (t == nt - 2);
            const char* a1 = cA + (size_t)(t + 1) * kstep;
            const char* a2 = last ? nA : cA + (size_t)(t + 2) * kstep; const char* b2 = last ? nB : cB + (size_t)(t + 2) * kstep;
            const char* a3 = a2 + kstep; const char* b3 = b2 + kstep;
            PG8_LDB(B0, 0, 0); PG8_LDB(B1, 0, 1); PG8_SCHED; PG8_LDA(At, 0, 0); PG8_STAGE(PG8_SA(1, 1), a1 + hstep, voffA);
            PG8_WAIT_V(8); PG8_WAIT_L(0); PG8_BAR; PG8_MMA(0, 0, At, B0); PG8_MMA(0, 1, At, B1); PG8_BAR; PG8_SCHED;
            PG8_LDA(At, 0, 1); PG8_STAGE(PG8_SB(0, 0), b2, voffB); PG8_STAGE(PG8_SB(0, 1), b2 + hstep, voffB); PG8_STAGE(PG8_SA(0, 0), a2, voffA);
            PG8_WAIT_V(8); PG8_WAIT_L(0); PG8_BAR; PG8_MMA(1, 0, At, B0); PG8_MMA(1, 1, At, B1); PG8_BAR; PG8_SCHED;
            PG8_LDB(B0, 1, 0); PG8_LDB(B1, 1, 1); PG8_SCHED; PG8_LDA(At, 1, 0); PG8_STAGE(PG8_SA(0, 1), a2 + hstep, voffA);
            PG8_WAIT_V(8); PG8_WAIT_L(0); PG8_BAR; PG8_MMA(0, 0, At, B0); PG8_MMA(0, 1, At, B1); PG8_BAR; PG8_SCHED;
            PG8_LDA(At, 1, 1); PG8_STAGE(PG8_SB(1, 0), b3, voffB); PG8_STAGE(PG8_SB(1, 1), b3 + hstep, voffB); PG8_STAGE(PG8_SA(1, 0), a3, voffA);
            PG8_WAIT_V(8); PG8_WAIT_L(0); PG8_BAR; PG8_MMA(1, 0, At, B0); PG8_MMA(1, 1, At, B1); PG8_BAR; PG8_SCHED;
        }
        if (wr == 0) PG8_BAR;
        E(acc, cur, wr, wc, fr, fq);
        if (!has_next) break;
#pragma unroll
        for (int a = 0; a < 2; ++a)
#pragma unroll
            for (int b = 0; b < 2; ++b)
#pragma unroll
                for (int m = 0; m < 4; ++m)
#pragma unroll
                    for (int n = 0; n < 2; ++n) acc[a][b][m][n] = (f32x4){0.f, 0.f, 0.f, 0.f};
        cur = nxt; cA = nA; cB = nB; ++ui;
        if (wr == 1) PG8_BAR;
    }
    PG8_WAIT_V(0);
    PG8_BAR;
#undef PG8_SA
#undef PG8_SB
#undef PG8_STAGE
#undef PG8_LDA
#undef PG8_LDB
#undef PG8_MMA
#undef PG8_WAIT_V
#undef PG8_WAIT_L
#undef PG8_BAR
#undef PG8_SCHED
}
}

#define LDS_WAIT() asm volatile("s_waitcnt lgkmcnt(0)" ::: "memory")
__device__ __forceinline__ unsigned f2bf(float f) { unsigned u = __builtin_bit_cast(unsigned, f); return (u + 0x7fffu + ((u >> 16) & 1u)) >> 16; }
__device__ __forceinline__ unsigned pk2(float lo, float hi) { return pg8::cvt_pk_bf16(lo, hi); }
__device__ __forceinline__ bf16_t f2bf1(float f) { return (bf16_t)(pg8::cvt_pk_bf16(f, f) & 0xffffu); }
__device__ __forceinline__ float bflo(unsigned w) { return __builtin_bit_cast(float, w << 16); }
__device__ __forceinline__ float bfhi(unsigned w) { return __builtin_bit_cast(float, w & 0xffff0000u); }
__device__ __forceinline__ float wave_sum(float v) {
#pragma unroll
    for (int o = 1; o < 64; o <<= 1) v += __shfl_xor(v, o);
    return v;
}

#define XB_TMO      128
#define XB_XCNT(j)  (256  + 64 * (j))
#define XB_XSUB(j)  (1280 + 64 * (j))
#define XB_XGEN(j)  (2304 + 64 * (j))
#define XB_TOP      3328
#define XB_TOPGEN   3392
#define XCD_BAR_WORDS 3456
#define XB_SPIN_CAP (1u << 18)

__device__ __forceinline__ unsigned xb_ld(unsigned* p)              { return __hip_atomic_load(p, __ATOMIC_RELAXED, __HIP_MEMORY_SCOPE_AGENT); }
__device__ __forceinline__ unsigned xb_add(unsigned* p, unsigned v) { return __hip_atomic_fetch_add(p, v, __ATOMIC_RELAXED, __HIP_MEMORY_SCOPE_AGENT); }
__device__ __forceinline__ unsigned xb_xcc_id() { return (unsigned)__builtin_amdgcn_s_getreg((3 << 11) | 20) & 0xFu; }
#define XB_SPIN(cond, bar) do { unsigned _sp = 0; while (cond) { \
    if ((++_sp & 255u) == 0u) { if (xb_ld(&(bar)[XB_TMO])) break; if (_sp > XB_SPIN_CAP) { atomicAdd(&(bar)[XB_TMO], 1u); break; } } } } while (0)

struct XcdBarrier {
    unsigned* bar; unsigned x;
    volatile LAS unsigned* st;
};

__device__ __forceinline__ XcdBarrier xcd_barrier_post(unsigned* bar, volatile LAS unsigned* st) {
    XcdBarrier b; b.bar = bar; b.x = xb_xcc_id(); b.st = st;
    if (threadIdx.x == 0) (void)xb_add(&bar[XB_XCNT(b.x)], 1u);
    return b;
}
__device__ __forceinline__ void xcd_barrier_complete(unsigned* bar, unsigned x, unsigned& nloc, unsigned& nx) {
    const unsigned G = gridDim.x * gridDim.y * gridDim.z;
    unsigned sum, cnt, mine, sp = 0u;
    for (;;) {
        sum = 0u; cnt = 0u; mine = 0u;
#pragma unroll
        for (unsigned j = 0; j < 16; ++j) { const unsigned c = xb_ld(&bar[XB_XCNT(j)]); sum += c; cnt += (c > 0u) ? 1u : 0u; mine = (j == x) ? c : mine; }
        if (sum == G) break;
        __builtin_amdgcn_s_sleep(1);
        if ((++sp & 255u) == 0u) { if (xb_ld(&bar[XB_TMO])) break; if (sp > XB_SPIN_CAP) { atomicAdd(&bar[XB_TMO], 1u); break; } }
    }
    nloc = mine > 0u ? mine : 1u; nx = cnt > 0u ? cnt : 1u;
}

__device__ __forceinline__ void xcd_barrier(const XcdBarrier& b) {
    asm volatile("s_waitcnt vmcnt(0)" ::: "memory");
    __syncthreads();
    if (threadIdx.x == 0) {
        unsigned* bar = b.bar;
        __builtin_amdgcn_s_waitcnt(0);
        unsigned nloc = b.st[0], nx = b.st[1];
        if (nloc == 0u) { xcd_barrier_complete(bar, b.x, nloc, nx); b.st[0] = nloc; b.st[1] = nx; }
        const unsigned old = xb_add(&bar[XB_XSUB(b.x)], 1u);
        const unsigned gen = old / nloc;
        if (old + 1u == (gen + 1u) * nloc) {
            __builtin_amdgcn_fence(__ATOMIC_RELEASE, "agent");
            asm volatile("s_waitcnt vmcnt(0)" ::: "memory");
            const unsigned og = xb_add(&bar[XB_TOP], 1u);
            const unsigned tg = og / nx;
            if (og + 1u == (tg + 1u) * nx) xb_add(&bar[XB_TOPGEN], 1u);
            else XB_SPIN(xb_ld(&bar[XB_TOPGEN]) == tg, bar);
            __builtin_amdgcn_fence(__ATOMIC_ACQUIRE, "agent");
            xb_add(&bar[XB_XGEN(b.x)], 1u);
            asm volatile("s_waitcnt vmcnt(0)" ::: "memory");
        } else {
            XB_SPIN(xb_ld(&bar[XB_XGEN(b.x)]) == gen, bar);
            __builtin_amdgcn_fence(__ATOMIC_ACQUIRE, "agent");
            asm volatile("s_waitcnt vmcnt(0)" ::: "memory");
        }
    }
    __syncthreads();
}


struct Ctx {
    LAS unsigned char* lds; int tid, lane, wave, vcu, G;
    float* out; unsigned char* ws;
};
struct Args { const float* in[23]; float* out; unsigned char* ws; int ph_lo, ph_hi; };
#define CIN(k) (A.in[k])

template <int MAP> __device__ __forceinline__ void p0_transpose_item(const float* W, int K, int N, bf16_t* WT, int row_off, LAS float* scr, int item, int lane, const float* gk = nullptr  ) {
    const int nblk = N / 32, kb = item / nblk, nb = item % nblk, k0 = 64 * kb, n0 = 32 * nb;
#pragma unroll 8
    for (int i = 0; i < 32; ++i) { const int kk = 2 * i + (lane >> 5); scr[kk * 33 + (lane & 31)] = W[(size_t)(k0 + kk) * N + n0 + (lane & 31)] * (gk ? gk[k0 + kk] : 1.0f); }
    LDS_WAIT(); asm volatile("" ::: "memory");
    int r0 = row_off + n0;
    if (MAP == 1) { const int half = n0 / DFF, f = n0 % DFF; r0 = (f / 128) * 256 + half * 128 + (f % 128); }
    const int c = lane & 7;
#pragma unroll
    for (int j = 0; j < 4; ++j) { const int n = (lane >> 3) + 8 * j; const LAS float* s = scr + (8 * c) * 33 + n;
        u32x4 o; o.x = pk2(s[0 * 33], s[1 * 33]); o.y = pk2(s[2 * 33], s[3 * 33]); o.z = pk2(s[4 * 33], s[5 * 33]); o.w = pk2(s[6 * 33], s[7 * 33]);
        *(u32x4*)(WT + (size_t)(r0 + n) * K + k0 + 8 * c) = o; }
    LDS_WAIT(); asm volatile("" ::: "memory");
}

__device__ __forceinline__ void ld8_bf16(f32x4& a, f32x4& b, const bf16_t* p) { const u32x4 w = *(const u32x4*)p; a = (f32x4){bflo(w.x), bfhi(w.x), bflo(w.y), bfhi(w.y)}; b = (f32x4){bflo(w.z), bfhi(w.z), bflo(w.w), bfhi(w.w)}; }
template <bool XIN_F32, bool HAS_MM> __device__ __forceinline__ void row_load(f32x4 (&v)[4], f32x4 (&m)[4], const void* xin, const bf16_t* mm, const bf16_t* pb, int ns, int lane) {
#pragma unroll
    for (int j = 0; j < 2; ++j) { const int e = 8 * lane + 512 * j;
        if (XIN_F32) { v[2 * j] = *(const f32x4*)((const float*)xin + e); v[2 * j + 1] = *(const f32x4*)((const float*)xin + e + 4); }
        else ld8_bf16(v[2 * j], v[2 * j + 1], (const bf16_t*)xin + e); }
    if (HAS_MM) {
#pragma unroll
        for (int j = 0; j < 2; ++j) { const int e = 8 * lane + 512 * j;
            if (pb) { ld8_bf16(m[2 * j], m[2 * j + 1], pb + e);
                for (int k = 1; k < ns; ++k) { f32x4 a, b; ld8_bf16(a, b, pb + (size_t)k * (MTS * D) + e); m[2 * j] = m[2 * j] + a; m[2 * j + 1] = m[2 * j + 1] + b; } }
            else ld8_bf16(m[2 * j], m[2 * j + 1], mm + e); }
    }
}
template <bool HAS_MM, bool OUT_F32, int WANT_RSTD  > __device__ __forceinline__ void row_finish(f32x4 (&v)[4], const f32x4 (&m)[4], const f32x4 (&g)[4], void* xout, float* rstd_out, int lane) {
    if (HAS_MM) {
        float s = 0.f;
#pragma unroll
        for (int j = 0; j < 4; ++j) s += (m[j].x * m[j].x + m[j].y * m[j].y) + (m[j].z * m[j].z + m[j].w * m[j].w);
        const float rs = __builtin_amdgcn_rsqf(wave_sum(s) * (1.f / D) + EPS);
#pragma unroll
        for (int j = 0; j < 4; ++j) v[j] = v[j] + m[j] * rs * g[j];
    }
#pragma unroll
    for (int j = 0; j < 2; ++j) { const int e = 8 * lane + 512 * j;
        if (OUT_F32) { *(f32x4*)((float*)xout + e) = v[2 * j]; *(f32x4*)((float*)xout + e + 4) = v[2 * j + 1]; }
        else { u32x4 w; w.x = pg8::cvt_pk_bf16(v[2 * j].x, v[2 * j].y); w.y = pg8::cvt_pk_bf16(v[2 * j].z, v[2 * j].w); w.z = pg8::cvt_pk_bf16(v[2 * j + 1].x, v[2 * j + 1].y); w.w = pg8::cvt_pk_bf16(v[2 * j + 1].z, v[2 * j + 1].w);
            *(u32x4*)((bf16_t*)xout + e) = w; } }
    if (WANT_RSTD) {
        float s = 0.f;
#pragma unroll
        for (int j = 0; j < 4; ++j) s += (v[j].x * v[j].x + v[j].y * v[j].y) + (v[j].z * v[j].z + v[j].w * v[j].w);
        const float tot = wave_sum(s);
        if (WANT_RSTD == 2) { if (lane < 4) rstd_out[lane] = lane == 0 ? tot : 0.f; }
        else if (lane == 0) rstd_out[0] = __builtin_amdgcn_rsqf(tot * (1.f / D) + EPS);
    }
}
template <bool XIN_F32, bool HAS_MM, bool OUT_F32, bool WANT_RSTD> __device__ __forceinline__ void row_op(const void* xin, const bf16_t* mm, const bf16_t* pb, int ns, const float* g1, void* xout, float* rstd_out, int lane) {
    f32x4 v[4], m[4], g[4];
#pragma unroll
    for (int j = 0; j < 4; ++j) g[j] = HAS_MM ? *(const f32x4*)(g1 + 8 * lane + 512 * (j >> 1) + 4 * (j & 1)) : (f32x4){0.f, 0.f, 0.f, 0.f};
    row_load<XIN_F32, HAS_MM>(v, m, xin, mm, pb, ns, lane);
    row_finish<HAS_MM, OUT_F32, WANT_RSTD>(v, m, g, xout, rstd_out, lane);
}
template <int XSRC, bool OUT_F32, bool WANT_RSTD> __device__ __forceinline__ void rowop_phase(const float* xp, const float* xs, bf16_t* XB, const bf16_t* MMb, const bf16_t* PB, int ns, const float* g1, float* outf, float* RSTD, int gw, int NGW, int lane) {
    f32x4 g[4];
#pragma unroll
    for (int j = 0; j < 4; ++j) g[j] = *(const f32x4*)(g1 + 8 * lane + 512 * (j >> 1) + 4 * (j & 1));
    for (int m0 = gw; m0 < MT; m0 += 2 * NGW) {
        const int m1 = m0 + NGW; const bool has1 = m1 < MT;
        f32x4 v0[4], q0[4], v1[4], q1[4];
        const void* x0 = XSRC == 0 ? (const void*)(m0 < MTP ? xp + (size_t)m0 * D : xs + (size_t)(m0 - MTP) * D) : (const void*)(XB + (size_t)m0 * D);
        row_load<XSRC == 0, true>(v0, q0, x0, MMb + (size_t)m0 * D, m0 >= MTP ? PB + (size_t)(m0 - MTP) * D : nullptr, ns, lane);
        if (has1) { const void* x1 = XSRC == 0 ? (const void*)(m1 < MTP ? xp + (size_t)m1 * D : xs + (size_t)(m1 - MTP) * D) : (const void*)(XB + (size_t)m1 * D);
            row_load<XSRC == 0, true>(v1, q1, x1, MMb + (size_t)m1 * D, m1 >= MTP ? PB + (size_t)(m1 - MTP) * D : nullptr, ns, lane); }
        row_finish<true, OUT_F32, WANT_RSTD>(v0, q0, g, OUT_F32 ? (void*)(outf + (size_t)m0 * D) : (void*)(XB + (size_t)m0 * D), RSTD + m0, lane);
        if (has1) row_finish<true, OUT_F32, WANT_RSTD>(v1, q1, g, OUT_F32 ? (void*)(outf + (size_t)m1 * D) : (void*)(XB + (size_t)m1 * D), RSTD + m1, lane);
    }
}

template <int XSRC, bool OUT_F32, bool WANT_RSTD> __device__ __forceinline__ void sample_rowop_after_gemm(const Ctx& C, const pg8::SchedTail& S, unsigned* cnt, const float* xs, bf16_t* XB, const bf16_t* PB, const float* g1, float* outf, float* RSTD) {
    pg8::Unit u; bool any = false;
    for (int i = 0; S.next(i, u); ++i) any |= (u.kind == 1);
    if (!any) return;
    if (C.tid == 0) {
        __builtin_amdgcn_fence(__ATOMIC_RELEASE, "agent"); asm volatile("s_waitcnt vmcnt(0)" ::: "memory");
        for (int i = 0; S.next(i, u); ++i) if (u.kind == 1) __hip_atomic_fetch_add(cnt + 64 * (u.pm - 64), 1u, __ATOMIC_RELAXED, __HIP_MEMORY_SCOPE_AGENT);
    }
    f32x4 g[4];
#pragma unroll
    for (int j = 0; j < 4; ++j) g[j] = *(const f32x4*)(g1 + 8 * C.lane + 512 * (j >> 1) + 4 * (j & 1));
    for (int i = 0; S.next(i, u); ++i) {
        if (u.kind != 1) continue;
        const unsigned target = 4u * (unsigned)S.NS; const int nrows = 256 / (4 * S.NS), r0 = u.pm * 256 + (u.pn * S.NS + u.ks) * nrows;
        if (C.tid == 0) { unsigned sp = 0;
            while (__hip_atomic_load(cnt + 64 * (u.pm - 64), __ATOMIC_RELAXED, __HIP_MEMORY_SCOPE_AGENT) < target) { __builtin_amdgcn_s_sleep(2); if (++sp > (1u << 22)) break; }
            __builtin_amdgcn_fence(__ATOMIC_ACQUIRE, "agent"); asm volatile("s_waitcnt vmcnt(0)" ::: "memory"); }
        __syncthreads();
        for (int k = C.wave; k < nrows; k += 8) {
            const int m0 = r0 + k; f32x4 v0[4], q0[4];
            const void* x0 = XSRC == 0 ? (const void*)(xs + (size_t)(m0 - MTP) * D) : (const void*)(XB + (size_t)m0 * D);
            row_load<XSRC == 0, true>(v0, q0, x0, nullptr, PB + (size_t)(m0 - MTP) * D, S.NS, C.lane);
            row_finish<true, OUT_F32, WANT_RSTD ? 2 : 0>(v0, q0, g, OUT_F32 ? (void*)(outf + (size_t)m0 * D) : (void*)(XB + (size_t)m0 * D), RSTD + (size_t)m0 * 4, C.lane);
        }
    }
}

template <int STAGE> __device__ __forceinline__ void p0_stage(const Ctx& C, const Args& A, int widx, int nw) {
    LAS float* scr = (LAS float*)(C.lds + C.wave * 16384);
    const int gw = widx * NWAVES + C.wave, NGW = nw * NWAVES;
    unsigned char* ws = C.ws; unsigned char* ob = (unsigned char*)C.out;
    constexpr int I_G1 = 16 * 192, I_G3 = 48 * 32, I_F1 = 16 * 176, I_F2 = 44 * 32, I_R1 = 16 * 64, I_R2 = 16 * 32, I_AX = 8;
    if constexpr (STAGE == 0) {
        for (int it = gw; it < I_G1; it += NGW) p0_transpose_item<0>(A.in[5], 1024, 6144, (bf16_t*)(ob + DO_WG1), 0, scr, it, C.lane, A.in[4] + 0 * D);
        for (int m = gw; m < MT; m += NGW) {
            const float* xr = m < MTP ? A.in[0] + (size_t)m * D : A.in[1] + (size_t)(m - MTP) * D;
            row_op<true, false, false, true>(xr, nullptr, nullptr, 0, nullptr, (bf16_t*)(ob + DO_HN) + (size_t)m * D, (float*)(ws + WS_RSTD) + m, C.lane);
        }
    }
    if constexpr (STAGE == 1) {
        constexpr int NITEMS = I_G3 + I_F1 + I_F2 + I_R1 + 16 * I_AX;
        for (int it = gw; it < NITEMS; it += NGW) {
            int r = it;
            if (r < I_G3) { p0_transpose_item<0>(A.in[11], 3072, 1024, (bf16_t*)(ws + WS_WG3), 0, scr, r, C.lane); continue; } r -= I_G3;
            if (r < I_F1) { p0_transpose_item<1>(A.in[21], 1024, 5632, (bf16_t*)(ws + WS_WF1), 0, scr, r, C.lane, A.in[4] + 2 * D); continue; } r -= I_F1;
            if (r < I_F2) { p0_transpose_item<0>(A.in[22], 2816, 1024, (bf16_t*)(ws + WS_WF2), 0, scr, r, C.lane); continue; } r -= I_F2;
            if (r < I_R1) { p0_transpose_item<0>(A.in[12], 1024, 2048, (bf16_t*)(ws + WS_WR1), 0, scr, r, C.lane, A.in[4] + 4 * D); continue; } r -= I_R1;
            { const int hg = r / I_AX, h = hg >> 1, gate = hg & 1;
              p0_transpose_item<0>((gate ? A.in[17] : A.in[15]) + (size_t)h * 16384, 128, 128, (bf16_t*)(ws + WS_WAX) + (size_t)h * 256 * 128, gate * 128, scr, r % I_AX, C.lane); }
        }
        const int gt = widx * NTHR + C.tid, NGT = nw * NTHR;
        for (int i = gt; i < 8 * 128 * 128; i += NGT) { const int t = (i >> 7) & 127, sx = i & 127; ((bf16_t*)(ws + WS_WSB))[i] = (bf16_t)f2bf(sx <= t ? A.in[9][i] : 0.f); }
        for (int i = gt; i < 1024; i += NGT) { const float l = A.in[19][i]; ((float*)(ws + WS_SP))[i] = (l < 0.f ? -l : 0.f) + log1pf(expf(-fabsf(l))); }
    }
    if constexpr (STAGE == 2) {
        constexpr int NITEMS = I_R2 + I_F1 + I_F2;
        for (int it = gw; it < NITEMS; it += NGW) {
            int r = it;
            if (r < I_R2) { p0_transpose_item<0>(A.in[20], 1024, 1024, (bf16_t*)(ws + WS_WR2), 0, scr, r, C.lane); continue; } r -= I_R2;
            if (r < I_F1) { p0_transpose_item<1>(A.in[21] + (size_t)1024 * 5632, 1024, 5632, (bf16_t*)(ws + WS_WF1B), 0, scr, r, C.lane, A.in[4] + 6 * D); continue; } r -= I_F1;
            p0_transpose_item<0>(A.in[22] + (size_t)2816 * 1024, 2816, 1024, (bf16_t*)(ws + WS_WF2B), 0, scr, r, C.lane);
        }
    }
}
template <int STAGE> __device__ __forceinline__ void p0_in_tail(const Ctx& C, const Args& A, int nunits, int bx) {
    const int nbusy = nunits % C.G;
    if (nbusy == 0) p0_stage<STAGE>(C, A, C.vcu, C.G);
    else if (bx >= nbusy) p0_stage<STAGE>(C, A, bx - nbusy, C.G - nbusy);
}

__device__ __forceinline__ void spatial_stats(const Ctx& C, int tok0, LAS float* RS, LAS float* MUR) {
    if (C.tid < 128) { const f32x2* ST = (const f32x2*)(C.ws + WS_ST); float s = 0.f, q = 0.f;
#pragma unroll 8
        for (int p = 0; p < 24; ++p) { const f32x2 v = ST[(size_t)p * MT + tok0 + C.tid]; s += v.x; q += v.y; }
        const float mean = s * (1.f / DG), var = q * (1.f / DG) - mean * mean, rstd = __builtin_amdgcn_rsqf(var + EPS);
        RS[C.tid] = rstd; MUR[C.tid] = mean * rstd; }
}
template <bool DRY> __device__ __forceinline__ void spatial_phase(const Ctx& C, const Args& A) {
    LAS unsigned char* lds = C.lds;
    LAS float* RS = (LAS float*)(lds + 34816); LAS float* MUR = (LAS float*)(lds + 36864);
    const int fr = C.lane & 15, fq = C.lane >> 4;
    bf16_t* U = (bf16_t*)(C.ws + WS_U); const bf16_t* VT = (const bf16_t*)(C.ws + WS_V); const bf16_t* WSB = (const bf16_t*)(C.ws + WS_WSB);
    const float* ln_g = A.in[7]; const float* ln_b = A.in[8]; const float* b_s = A.in[10]; const float* w_s = A.in[9];
    const f32x2* ST = (const f32x2*)(C.ws + WS_ST);
    for (int base = C.vcu; base < 1024; base += 4 * C.G) {
        const int g = base & 7;
        __syncthreads();
        { const int i = C.tid >> 7, t = C.tid & 127, id = base + C.G * i;
          if (id < 1024) { const int tok = (id >> 3) * 128 + t; float sm = 0.f, q = 0.f;
#pragma unroll 8
            for (int p = 0; p < 24; ++p) { const f32x2 v = ST[(size_t)p * MT + tok]; sm += v.x; q += v.y; }
            const float mean = sm * (1.f / DG), var = q * (1.f / DG) - mean * mean, rstd = __builtin_amdgcn_rsqf(var + EPS);
            RS[C.tid] = rstd; MUR[C.tid] = mean * rstd; } }
#pragma unroll
        for (int i = 0; i < 4; ++i) { const int p = C.tid + 512 * i, row = p >> 4, c16 = p & 15;
            const u32x4 w = *(const u32x4*)(WSB + (size_t)g * 16384 + row * 128 + c16 * 8); *(LAS u32x4*)(lds + row * 272 + c16 * 16) = w; }
        __syncthreads();
        float bsv[8];
#pragma unroll
        for (int m = 0; m < 8; ++m) bsv[m] = b_s[g * 128 + 16 * m + fr];
        u32x4 rB[3][4]; u32x2 rU[3][8]; float rG[3], rBn[3];
#define SP_ISSUE(s_) do { const int i_ = (s_) / 3, j_ = (s_) % 3, sl_ = (s_) % 3, id_ = base + C.G * i_; if (id_ < 1024) { const int tok0_ = (id_ >> 3) * 128, chb_ = g * 384 + 48 * C.wave + 16 * j_; \
            rG[sl_] = ln_g[chb_ + fr]; rBn[sl_] = ln_b[chb_ + fr]; \
            _Pragma("unroll") for (int kk = 0; kk < 4; ++kk) rB[sl_][kk] = *(const u32x4*)(VT + (size_t)(chb_ + fr) * MT + tok0_ + 32 * kk + 8 * fq); \
            _Pragma("unroll") for (int m = 0; m < 8; ++m) rU[sl_][m] = *(const u32x2*)(U + (size_t)(tok0_ + 16 * m + fr) * DG + chb_ + 4 * fq); } } while (0)
        SP_ISSUE(0); SP_ISSUE(1);
#pragma unroll
        for (int s = 0; s < 12; ++s) {
            if (s + 2 < 12) SP_ISSUE(s + 2);
            const int i = s / 3, j = s % 3, sl = s % 3, id = base + C.G * i;
            if (id < 1024) {
                const int tok0 = (id >> 3) * 128, chb = g * 384 + 48 * C.wave + 16 * j;
                const float Gc = rG[sl], Bc = rBn[sl];
                bf16x8 bfrag[4];
#pragma unroll
                for (int kk = 0; kk < 4; ++kk) {
                    const u32x4 raw = rB[sl][kk];
                    const LAS float* rp = RS + i * 128 + 32 * kk + 8 * fq; const LAS float* mp = MUR + i * 128 + 32 * kk + 8 * fq;
                    const f32x4 r0 = *(const LAS f32x4*)rp, r1 = *(const LAS f32x4*)(rp + 4), m0 = *(const LAS f32x4*)mp, m1 = *(const LAS f32x4*)(mp + 4);
                    const f32x4 vlo = (f32x4){bflo(raw.x), bfhi(raw.x), bflo(raw.y), bfhi(raw.y)}, vhi = (f32x4){bflo(raw.z), bfhi(raw.z), bflo(raw.w), bfhi(raw.w)};
                    const f32x4 o0 = vlo * (r0 * Gc) + (Bc - m0 * Gc), o1 = vhi * (r1 * Gc) + (Bc - m1 * Gc);
                    u32x4 w; w.x = pg8::cvt_pk_bf16(o0.x, o0.y); w.y = pg8::cvt_pk_bf16(o0.z, o0.w); w.z = pg8::cvt_pk_bf16(o1.x, o1.y); w.w = pg8::cvt_pk_bf16(o1.z, o1.w);
                    bfrag[kk] = __builtin_bit_cast(bf16x8, w);
                }
#pragma unroll
                for (int m = 0; m < 8; ++m) { f32x4 acc = (f32x4){0.f, 0.f, 0.f, 0.f};
#pragma unroll
                    for (int kk = 0; kk < 4; ++kk) if (kk <= (m >> 1)) {
                        const bf16x8 af = *(const LAS bf16x8*)(lds + (16 * m + fr) * 272 + (32 * kk + 8 * fq) * 2);
                        acc = __builtin_amdgcn_mfma_f32_16x16x32_bf16(bfrag[kk], af, acc, 0, 0, 0); }
                    const float bs = bsv[m]; const u32x2 uw = rU[sl][m];
                    u32x2 o; o.x = pg8::cvt_pk_bf16(bflo(uw.x) * (acc[0] + bs), bfhi(uw.x) * (acc[1] + bs)); o.y = pg8::cvt_pk_bf16(bflo(uw.y) * (acc[2] + bs), bfhi(uw.y) * (acc[3] + bs));
                    *(u32x2*)(U + (size_t)(tok0 + 16 * m + fr) * DG + chb + 4 * fq) = o; }
            }
        }
#undef SP_ISSUE
    }
    for (int r = C.vcu; r < 256; r += C.G) {
        const int sc = r >> 5, g = (r >> 2) & 7, quarter = r & 3, tok0 = MTP + sc * 128;
        __syncthreads();
        if (C.tid < 128) { float sm = 0.f, q = 0.f;
#pragma unroll 8
            for (int p = 0; p < 24; ++p) { const f32x2 v = ST[(size_t)p * MT + tok0 + C.tid]; sm += v.x; q += v.y; }
            const float mean = sm * (1.f / DG), var = q * (1.f / DG) - mean * mean, rstd = __builtin_amdgcn_rsqf(var + EPS);
            RS[C.tid] = rstd; MUR[C.tid] = mean * rstd; }
        __syncthreads();
        float* OV = C.out + O_SV;
#pragma unroll
        for (int p4 = 0; p4 < 3; ++p4) { const int p = C.tid + NTHR * p4;
            const int dbl = p / 96, cl = p - dbl * 96, ch = g * 384 + quarter * 96 + cl, db = sc * 16 + dbl;
            const float Gc = ln_g[ch], Bc = ln_b[ch];
            const u32x4 raw = *(const u32x4*)(VT + (size_t)ch * MT + MTP + db * 8);
            float vn[8]; const float vv[8] = {bflo(raw.x), bfhi(raw.x), bflo(raw.y), bfhi(raw.y), bflo(raw.z), bfhi(raw.z), bflo(raw.w), bfhi(raw.w)};
#pragma unroll
            for (int sx = 0; sx < 8; ++sx) { vn[sx] = vv[sx] * (RS[dbl * 8 + sx] * Gc) + (Bc - MUR[dbl * 8 + sx] * Gc); OV[(size_t)(db * 8 + sx) * DG + ch] = vn[sx]; }
#pragma unroll
            for (int t = 0; t < 8; ++t) { float mx = b_s[g * 128 + t];
#pragma unroll
                for (int sx = 0; sx <= t; ++sx) mx += w_s[g * 16384 + t * 128 + sx] * vn[sx];
                bf16_t* up = U + (size_t)(MTP + db * 8 + t) * DG + ch; *up = (bf16_t)f2bf(bflo((unsigned)*up) * mx); }
        }
    }
    __syncthreads();
}

constexpr int RG_TILE = 64, RG_NT = MT / RG_TILE  , RG_NTP = MTP / RG_TILE  , RG_PITCH = 132;
__device__ __forceinline__ float one_minus_exp(float x, float ex  ) {
    float p = x * (1.f / 5040.f) + (1.f / 720.f); p = p * x + (1.f / 120.f); p = p * x + (1.f / 24.f); p = p * x + (1.f / 6.f); p = p * x + 0.5f; p = p * x + 1.0f; p = -(p * x);
    const float e = 1.0f - ex;
    return x > -0.3f ? p : e;
}
__device__ __forceinline__ void rg_phase1(const Ctx& C, const Args& A) {
    LAS unsigned char* lds = C.lds;
    LAS float* XC = (LAS float*)(lds + 69632); LAS float* BB = XC; LAS float* AA = (LAS float*)(lds + 103424); LAS f32x2* SUM = (LAS f32x2*)(lds + 137216);
    const int fr = C.lane & 15, fq = C.lane >> 4, h = C.vcu & 7;
    const bf16_t* XBR = (const bf16_t*)(C.ws + WS_U) + (size_t)MT * D; const bf16_t* WAX = (const bf16_t*)(C.ws + WS_WAX); const float* SP = (const float*)(C.ws + WS_SP);
    bf16_t* GATE = (bf16_t*)(C.ws + WS_U); f32x2* TS = (f32x2*)(C.ws + WS_TS); unsigned* FLG = (unsigned*)(C.ws + WS_FLG); LAS float* CARRY = (LAS float*)(lds + 137216 + 4096);
    const float* conv_w = A.in[13]; const float* conv_b = A.in[14]; const float* b_a = A.in[16]; const float* b_x = A.in[18]; const float* st_conv = A.in[2]; const float* st_h = A.in[3];
#pragma unroll
    for (int i = 0; i < 8; ++i) { const int p = C.tid + 512 * i, row = p >> 4, c16 = p & 15; *(LAS u32x4*)(lds + row * 272 + c16 * 16) = *(const u32x4*)(WAX + ((size_t)h * 256 + row) * 128 + c16 * 8); }
    const int cg8 = C.tid & 15, tr = C.tid >> 4, c8 = h * 128 + cg8 * 8;
    f32x4 w[4][2], bb[2];
#pragma unroll
    for (int k = 0; k < 4; ++k) { w[k][0] = *(const f32x4*)(conv_w + k * 1024 + c8); w[k][1] = *(const f32x4*)(conv_w + k * 1024 + c8 + 4); }
    bb[0] = *(const f32x4*)(conv_b + c8); bb[1] = *(const f32x4*)(conv_b + c8 + 4);
    const int mb = C.wave & 3, nh = C.wave >> 2;
    LAS float* HC = (LAS float*)(lds + 141824);
    if (C.tid < 128) { HC[C.tid] = b_a[h * 128 + C.tid]; HC[128 + C.tid] = b_x[h * 128 + C.tid]; HC[256 + C.tid] = SP[h * 128 + C.tid]; }
    u32x4 pre[2][4];
#define RG_LOADROWS(tile_) do { const int tok0_ = (tile_) * RG_TILE; const bool smp_ = (tile_) >= RG_NTP; \
        _Pragma("unroll") for (int i = 0; i < 2; ++i) { const int tok_ = tok0_ + tr + 32 * i, tl_ = smp_ ? ((tok_ - MTP) & 7) : (tok_ & (SEQ - 1)); \
            _Pragma("unroll") for (int k = 0; k < 4; ++k) { pre[i][k] = (u32x4){0u, 0u, 0u, 0u}; if (tl_ + k - 3 >= 0) pre[i][k] = *(const u32x4*)(XBR + (size_t)(tok_ + k - 3) * D + c8); } } } while (0)
    if (C.vcu < RG_NT * 8) RG_LOADROWS(C.vcu >> 3);
    __syncthreads();
    for (int id = C.vcu; id < RG_NT * 8; id += C.G) {
        const int tile = id >> 3, tok0 = tile * RG_TILE; const bool sample = tile >= RG_NTP;
        {
#pragma unroll
            for (int i = 0; i < 2; ++i) { const int t = tr + 32 * i, tok = tok0 + t;
                const int L = sample ? 8 : SEQ, tl = sample ? ((tok - MTP) & 7) : (tok & (SEQ - 1)), sq = sample ? ((tok - MTP) >> 3) : (tok >> 11);
                f32x4 x0 = bb[0], x1 = bb[1];
#pragma unroll
                for (int k = 0; k < 4; ++k) { const u32x4 raw = pre[i][k];
                    f32x4 r0 = (f32x4){bflo(raw.x), bfhi(raw.x), bflo(raw.y), bfhi(raw.y)}, r1 = (f32x4){bflo(raw.z), bfhi(raw.z), bflo(raw.w), bfhi(raw.w)};
                    if (sample && tl + k - 3 < 0) { const float* hp = st_conv + (size_t)(sq * 3 + (tl + k)) * D + c8; r0 = *(const f32x4*)hp; r1 = *(const f32x4*)(hp + 4); }
                    x0 = x0 + w[k][0] * r0; x1 = x1 + w[k][1] * r1;
                    if (k == 3 && tl >= L - 3) { float* op = C.out + (sample ? O_SCONV : O_PCONV) + (size_t)(sq * 3 + (tl - (L - 3))) * D + c8; *(f32x4*)op = r0; *(f32x4*)(op + 4) = r1; } }
                *(LAS f32x4*)(XC + t * RG_PITCH + cg8 * 8) = x0; *(LAS f32x4*)(XC + t * RG_PITCH + cg8 * 8 + 4) = x1; }
        }
        __syncthreads();
        bf16x8 af[4]; f32x4 xc4[4];
        {
#pragma unroll
            for (int kk = 0; kk < 4; ++kk) { const LAS float* xp = XC + (16 * mb + fr) * RG_PITCH + 32 * kk + 8 * fq; const f32x4 a0 = *(const LAS f32x4*)xp, a1 = *(const LAS f32x4*)(xp + 4);
                u32x4 wv; wv.x = pg8::cvt_pk_bf16(a0.x, a0.y); wv.y = pg8::cvt_pk_bf16(a0.z, a0.w); wv.z = pg8::cvt_pk_bf16(a1.x, a1.y); wv.w = pg8::cvt_pk_bf16(a1.z, a1.w); af[kk] = __builtin_bit_cast(bf16x8, wv); }
#pragma unroll
            for (int nb = 0; nb < 4; ++nb) xc4[nb] = *(const LAS f32x4*)(XC + (16 * mb + fr) * RG_PITCH + 64 * nh + 16 * nb + 4 * fq);
        }
        __syncthreads();
        if (id + C.G < RG_NT * 8) RG_LOADROWS((id + C.G) >> 3);
        u32x4 gpre[2];
#pragma unroll
        for (int i = 0; i < 2; ++i) { const int p = C.tid + 512 * i; gpre[i] = *(const u32x4*)(GATE + (size_t)(tok0 + (p >> 4)) * D + h * 128 + (p & 15) * 8); }
        {
#pragma unroll
            for (int nb = 0; nb < 4; ++nb) {
                f32x4 ra = (f32x4){0.f, 0.f, 0.f, 0.f}, ia = ra;
                const LAS unsigned char* wp = lds + (64 * nh + 16 * nb + fr) * 272 + 16 * fq;
#pragma unroll
                for (int kk = 0; kk < 4; ++kk) { const bf16x8 ba = *(const LAS bf16x8*)(wp + 64 * kk), bx = *(const LAS bf16x8*)(wp + 128 * 272 + 64 * kk);
                    ra = __builtin_amdgcn_mfma_f32_16x16x32_bf16(ba, af[kk], ra, 0, 0, 0); ia = __builtin_amdgcn_mfma_f32_16x16x32_bf16(bx, af[kk], ia, 0, 0, 0); }
                const int t = 16 * mb + fr, cl = 64 * nh + 16 * nb + 4 * fq;
                f32x4 av, bv; const f32x4 bav = *(const LAS f32x4*)(HC + cl), bxv = *(const LAS f32x4*)(HC + 128 + cl), spv = *(const LAS f32x4*)(HC + 256 + cl);
#pragma unroll
                for (int j = 0; j < 4; j += 2) {
                    const f32x2 zr = ((f32x2){ra[j], ra[j + 1]} + (f32x2){bav[j], bav[j + 1]}) * -1.4426950409f, zi = ((f32x2){ia[j], ia[j + 1]} + (f32x2){bxv[j], bxv[j + 1]}) * -1.4426950409f;
                    f32x2 er, ei; er.x = __builtin_amdgcn_exp2f(zr.x); er.y = __builtin_amdgcn_exp2f(zr.y); ei.x = __builtin_amdgcn_exp2f(zi.x); ei.y = __builtin_amdgcn_exp2f(zi.y);
                    const f32x2 dr = er + 1.0f, di = ei + 1.0f; f32x2 r, ii; r.x = __builtin_amdgcn_rcpf(dr.x); r.y = __builtin_amdgcn_rcpf(dr.y); ii.x = __builtin_amdgcn_rcpf(di.x); ii.y = __builtin_amdgcn_rcpf(di.y);
                    const f32x2 la = r * (f32x2){spv[j], spv[j + 1]} * -8.0f, le = la * 1.4426950409f; f32x2 a; a.x = __builtin_amdgcn_exp2f(le.x); a.y = __builtin_amdgcn_exp2f(le.y);
                    const f32x2 x2 = la * 2.0f;
                    f32x2 p = x2 * (1.f / 5040.f) + (1.f / 720.f); p = p * x2 + (1.f / 120.f); p = p * x2 + (1.f / 24.f); p = p * x2 + (1.f / 6.f); p = p * x2 + 0.5f; p = p * x2 + 1.0f; p = -(p * x2);
                    const f32x2 e = 1.0f - a * a; f32x2 om; om.x = x2.x > -0.3f ? p.x : e.x; om.y = x2.y > -0.3f ? p.y : e.y;
                    f32x2 sq; sq.x = __builtin_amdgcn_sqrtf(om.x); sq.y = __builtin_amdgcn_sqrtf(om.y);
                    const f32x2 b2 = sq * (ii * (f32x2){xc4[nb][j], xc4[nb][j + 1]});
                    av[j] = a.x; av[j + 1] = a.y; bv[j] = b2.x; bv[j + 1] = b2.y; }
                *(LAS f32x4*)(AA + t * RG_PITCH + cl) = av; *(LAS f32x4*)(BB + t * RG_PITCH + cl) = bv;
            }
        }
        __syncthreads();
        {
            const int chl = C.tid & 127, q = C.tid >> 7, ch = h * 128 + chl;
            if (!sample) {
                float Ap = 1.f, Bp = 0.f;
#pragma unroll 4
                for (int t = 16 * q; t < 16 * q + 16; ++t) { const float a = AA[t * RG_PITCH + chl], b = BB[t * RG_PITCH + chl]; Bp = a * Bp + b; Ap *= a; }
                SUM[q * 128 + chl] = (f32x2){Ap, Bp};
                __syncthreads();
                const int first = tile & ~31, nprev = tile & 31;
                if (C.tid < 128) { float At = 1.f, Bt = 0.f;
#pragma unroll
                    for (int qq = 0; qq < 4; ++qq) { const f32x2 sm = SUM[qq * 128 + chl]; Bt = sm.x * Bt + sm.y; At *= sm.x; }
                    __hip_atomic_store((unsigned long long*)(TS + (size_t)tile * D + ch), ((unsigned long long)__float_as_uint(Bt) << 32) | __float_as_uint(At), __ATOMIC_RELAXED, __HIP_MEMORY_SCOPE_AGENT); }
                asm volatile("s_waitcnt vmcnt(0)" ::: "memory");
                __syncthreads();
                if (C.tid == 0) __hip_atomic_store(FLG + (size_t)(tile * 8 + h) * 16, 1u, __ATOMIC_RELAXED, __HIP_MEMORY_SCOPE_AGENT);
                if (C.wave == 0) { unsigned sp = 0;
                    for (;;) { const unsigned f = C.lane < nprev ? __hip_atomic_load(FLG + (size_t)((first + C.lane) * 8 + h) * 16, __ATOMIC_RELAXED, __HIP_MEMORY_SCOPE_AGENT) : 1u;
                        if (__builtin_amdgcn_ballot_w64(f == 0u) == 0ull) break; __builtin_amdgcn_s_sleep(2); if (++sp > (1u << 22)) break; }
                    __builtin_amdgcn_fence(__ATOMIC_ACQUIRE, "agent"); }
                asm volatile("s_waitcnt vmcnt(0)" ::: "memory");
                __syncthreads();
                if (C.tid < 128) { float carry = 0.f;
#pragma unroll
                    for (int j0 = 0; j0 < 32; j0 += 16) { unsigned long long sv[16];
#pragma unroll
                        for (int j = 0; j < 16; ++j) sv[j] = (j0 + j < nprev) ? __hip_atomic_load((const unsigned long long*)(TS + (size_t)(first + j0 + j) * D + ch), __ATOMIC_RELAXED, __HIP_MEMORY_SCOPE_AGENT) : 0x000000003f800000ull;
#pragma unroll
                        for (int j = 0; j < 16; ++j) carry = __uint_as_float((unsigned)sv[j]) * carry + __uint_as_float((unsigned)(sv[j] >> 32)); }
                    CARRY[chl] = carry; }
                __syncthreads();
                float hv = CARRY[chl];
                for (int qq = 0; qq < q; ++qq) { const f32x2 sm = SUM[qq * 128 + chl]; hv = sm.x * hv + sm.y; }
#pragma unroll 4
                for (int t = 16 * q; t < 16 * q + 16; ++t) { hv = AA[t * RG_PITCH + chl] * hv + BB[t * RG_PITCH + chl]; AA[t * RG_PITCH + chl] = hv; }
                if (q == 3 && nprev == 31) C.out[O_PH + (size_t)(tile >> 5) * D + ch] = hv;
            } else {
#pragma unroll
                for (int s2 = 0; s2 < 2; ++s2) { const int db = ((tok0 - MTP) >> 3) + 2 * q + s2; float hv = st_h[(size_t)db * D + ch];
#pragma unroll
                    for (int t8 = 0; t8 < 8; ++t8) { const int t = 16 * q + 8 * s2 + t8; hv = AA[t * RG_PITCH + chl] * hv + BB[t * RG_PITCH + chl]; AA[t * RG_PITCH + chl] = hv; }
                    C.out[O_SH + (size_t)db * D + ch] = hv; }
            }
        }
        __syncthreads();
#pragma unroll
        for (int i = 0; i < 2; ++i) { const int p = C.tid + 512 * i, t = p >> 4, c8l = (p & 15) * 8;
            const f32x4 h0 = *(const LAS f32x4*)(AA + t * RG_PITCH + c8l), h1 = *(const LAS f32x4*)(AA + t * RG_PITCH + c8l + 4); const u32x4 gt = gpre[i];
            u32x4 o; o.x = pg8::cvt_pk_bf16(h0.x * bflo(gt.x), h0.y * bfhi(gt.x)); o.y = pg8::cvt_pk_bf16(h0.z * bflo(gt.y), h0.w * bfhi(gt.y)); o.z = pg8::cvt_pk_bf16(h1.x * bflo(gt.z), h1.y * bfhi(gt.z)); o.w = pg8::cvt_pk_bf16(h1.z * bflo(gt.w), h1.w * bfhi(gt.w));
            *(u32x4*)(GATE + (size_t)(tok0 + t) * D + h * 128 + c8l) = o; }
        __syncthreads();
    }
#undef RG_LOADROWS
}
template <bool DRY> __device__ __forceinline__ void rg_phase2(const Ctx& C) {
    LAS float* CARRY = (LAS float*)C.lds;
    bf16_t* GATE = (bf16_t*)(C.ws + WS_U); const bf16_t* HL = (const bf16_t*)(C.ws + WS_V); const bf16_t* CA = (const bf16_t*)(C.ws + WS_V + (size_t)MT * D * 4); const f32x2* TS = (const f32x2*)(C.ws + WS_TS);
    for (int id = C.vcu; id < RG_NT * 8; id += C.G) {
        const int tile = id >> 3, h = id & 7, tok0 = tile * RG_TILE; const bool sample = tile >= RG_NTP;
        if (C.tid < 128) { const int ch = h * 128 + C.tid; float carry = 0.f;
            if (!sample) { const int first = tile & ~31, nprev = tile & 31;
                f32x2 sv[31];
#pragma unroll
                for (int j = 0; j < 31; ++j) sv[j] = (j < nprev) ? TS[(size_t)(first + j) * D + ch] : (f32x2){1.f, 0.f};
#pragma unroll
                for (int j = 0; j < 31; ++j) carry = sv[j].x * carry + sv[j].y; }
            CARRY[C.tid] = carry; }
        __syncthreads();
#pragma unroll
        for (int i = 0; i < 2; ++i) { const int p = C.tid + 512 * i, t = p >> 4, cg8 = p & 15, tok = tok0 + t, c8 = h * 128 + cg8 * 8; const size_t off = (size_t)tok * D + c8;
            const u32x4 hlw = *(const u32x4*)(HL + off); const f32x4 h0 = (f32x4){bflo(hlw.x), bfhi(hlw.x), bflo(hlw.y), bfhi(hlw.y)}, h1 = (f32x4){bflo(hlw.z), bfhi(hlw.z), bflo(hlw.w), bfhi(hlw.w)}; const u32x4 ca = *(const u32x4*)(CA + off), gt = *(const u32x4*)(GATE + off);
            const f32x4 c0 = *(const LAS f32x4*)(CARRY + cg8 * 8), c1 = *(const LAS f32x4*)(CARRY + cg8 * 8 + 4);
            f32x4 v0 = h0, v1 = h1;
            if (!sample) { v0 = v0 + (f32x4){bflo(ca.x), bfhi(ca.x), bflo(ca.y), bfhi(ca.y)} * c0; v1 = v1 + (f32x4){bflo(ca.z), bfhi(ca.z), bflo(ca.w), bfhi(ca.w)} * c1; }
            u32x4 o; o.x = pk2(v0.x * bflo(gt.x), v0.y * bfhi(gt.x)); o.y = pk2(v0.z * bflo(gt.y), v0.w * bfhi(gt.y)); o.z = pk2(v1.x * bflo(gt.z), v1.y * bfhi(gt.z)); o.w = pk2(v1.z * bflo(gt.w), v1.w * bfhi(gt.w));
            *(u32x4*)((DRY ? GATE + (size_t)2 * MT * D : GATE) + off) = o;
            if (!sample && (tok & (SEQ - 1)) == SEQ - 1) { float* op = C.out + O_PH + (size_t)(tok >> 11) * D + c8; *(f32x4*)op = v0; *(f32x4*)(op + 4) = v1; } }
        __syncthreads();
    }
}

template <int K, bool DRY = false> __device__ __forceinline__ void run_phase(const Ctx& C, const Args& args) {
    unsigned char* ws = args.ws; unsigned char* ob = (unsigned char*)args.out;
    bf16_t* const Ubuf = (bf16_t*)(ws + WS_U); bf16_t* const Vbuf = (bf16_t*)(ws + WS_V);
    bf16_t* const MMb = Vbuf;
    bf16_t* const HNb = Vbuf + (size_t)MT * D;
    bf16_t* const PB = (bf16_t*)(ws + WS_V + 68 * MiB);
    constexpr int NS_G3 = 8, NS_F2 = 8, NS_G9 = 4;
    const int gw = C.vcu * NWAVES + C.wave, NGW = C.G * NWAVES;
    const float* gains = args.in[4]; float* const RSTD = (float*)(ws + WS_RSTD);
    unsigned* const ECNT = (unsigned*)(ws + WS_CNT); unsigned* const SCNT = ECNT + 4 * 2 * 64 * 64;
    float* const XS1 = (float*)(ws + WS_ST); float* const RS16 = (float*)(ws + WS_ST + 2560 * 1024);
    const int bx = (int)blockIdx.x;

    if constexpr (K == 0) { p0_stage<0>(C, args, C.vcu, C.G); }
    if constexpr (K == 1) {
        const bf16_t* hn0 = (const bf16_t*)(ob + DO_HN); const bf16_t* wg1 = (const bf16_t*)(ob + DO_WG1);
        pg8::Sched S; S.init(hn0, wg1, MT, DG, wg1 + (size_t)DG * D, hn0, DG, MT, D, C.G, bx);
        pg8::EpiG1 E{Ubuf, Vbuf, args.in[6], (f32x2*)(ws + WS_ST), RSTD};
        pg8::gemm_phase(C.lds, D, S, E);
        if (!DRY) p0_in_tail<1>(C, args, 68 * 24, bx);
    }
    if constexpr (K == 2) { spatial_phase<DRY>(C, args); }
    if constexpr (K == 3) {
        pg8::SchedTail S; S.init(Ubuf, ws + WS_WG3, DG, NS_G3, C.G, bx);
        pg8::RmsExchange e1{XS1, ECNT + (0 * 2 + 0) * 4096};
        pg8::EpiTailFused<false> E{PB, e1, (const bf16_t*)(ob + DO_HN), HNb, gains + 1 * D, nullptr, RS16, C.lds + 131072};   pg8::gemm_phase(C.lds, DG, S, E);
        sample_rowop_after_gemm<0, false, true>(C, S, SCNT + 0 * 256, args.in[1], HNb, PB, gains + 1 * D, nullptr, RS16);
    }
    if constexpr (K == 4) {
    }
    if constexpr (K == 5) {
        pg8::Sched S; S.init(HNb, ws + WS_WF1, MT, 2 * DFF, nullptr, nullptr, 0, 0, D, C.G, bx);
        pg8::EpiSwiglu E{Ubuf, RS16}; pg8::gemm_phase(C.lds, D, S, E);
    }
    if constexpr (K == 6) {
        pg8::SchedTail S; S.init(Ubuf, ws + WS_WF2, DFF, NS_F2, C.G, bx);
        pg8::RmsExchange e1{XS1, ECNT + (1 * 2 + 0) * 4096};
        pg8::EpiTailFused<false> E{PB, e1, HNb, HNb, gains + 3 * D, nullptr, RS16, C.lds + 131072}; pg8::gemm_phase(C.lds, DFF, S, E);
        sample_rowop_after_gemm<1, false, true>(C, S, SCNT + 1 * 256, nullptr, HNb, PB, gains + 3 * D, nullptr, RS16);
    }
    if constexpr (K == 7) {
    }
    if constexpr (K == 8) {
        pg8::Sched S; S.init(HNb, ws + WS_WR1, MT, 2 * D, nullptr, nullptr, 0, 0, D, C.G, bx);
        pg8::EpiG6 E{Ubuf, Ubuf + (size_t)MT * D, RS16}; pg8::gemm_phase(C.lds, D, S, E);
        if (!DRY) p0_in_tail<2>(C, args, 68 * 8, bx);
    }
    if constexpr (K == 9) { rg_phase1(C, args); }
    if constexpr (K == 11) {
        pg8::SchedTail S; S.init(Ubuf, ws + WS_WR2, D, NS_G9, C.G, bx);
        pg8::RmsExchange e1{XS1, ECNT + (2 * 2 + 0) * 4096};
        pg8::EpiTailFused<false> E{PB, e1, HNb, HNb, gains + 5 * D, nullptr, RS16, C.lds + 131072}; pg8::gemm_phase(C.lds, D, S, E);
        sample_rowop_after_gemm<1, false, true>(C, S, SCNT + 2 * 256, nullptr, HNb, PB, gains + 5 * D, nullptr, RS16);
    }
    if constexpr (K == 12) {
    }
    if constexpr (K == 13) {
        pg8::Sched S; S.init(HNb, ws + WS_WF1B, MT, 2 * DFF, nullptr, nullptr, 0, 0, D, C.G, bx);
        pg8::EpiSwiglu E{Ubuf, RS16}; pg8::gemm_phase(C.lds, D, S, E);
    }
    if constexpr (K == 14) {
        pg8::SchedTail S; S.init(Ubuf, ws + WS_WF2B, DFF, NS_F2, C.G, bx);
        pg8::RmsExchange e1{XS1, ECNT + (3 * 2 + 0) * 4096};
        pg8::EpiTailFused<true> E{PB, e1, HNb, HNb, gains + 7 * D, args.out, RS16, C.lds + 131072}; pg8::gemm_phase(C.lds, DFF, S, E);
        sample_rowop_after_gemm<1, true, false>(C, S, SCNT + 3 * 256, nullptr, HNb, PB, gains + 7 * D, args.out, RS16);
    }
    if constexpr (K == 15) {
    }
}
constexpr int NPH = 16;
__global__ void __launch_bounds__(NTHR, 2) fwd_kernel(Args args) {
    extern __shared__ __attribute__((aligned(16))) unsigned char lds_raw[];
    Ctx C; C.lds = (LAS unsigned char*)lds_raw; C.tid = threadIdx.x; C.lane = C.tid & 63; C.wave = __builtin_amdgcn_readfirstlane(C.tid >> 6);
    C.G = gridDim.x; { const int bx = blockIdx.x; C.vcu = (C.G % 8 == 0) ? (bx % 8) * (C.G / 8) + bx / 8 : bx; }
    C.out = args.out; C.ws = args.ws;
    for (int u = C.tid; u < 64; u += NTHR) ((LAS unsigned*)(C.lds + LDS_BYTES - 256))[u] = 0u;
    __syncthreads();
    const XcdBarrier bar = xcd_barrier_post((unsigned*)(args.ws + WS_BAR), (volatile LAS unsigned*)(C.lds + LDS_BYTES - 256 + 32));
    const int lo = args.ph_lo, hi = args.ph_hi;
#ifndef REP_MASK
#define REP_MASK 0
#endif
#ifndef XSYNC
#define XSYNC 0
#endif
#define REPS(k) (((REP_MASK >> (k)) & 1) ? 2 : 1)
#ifndef PH_MASK
#define PH_MASK 0xffff
#endif
#define IN(k) (((PH_MASK >> (k)) & 1) && lo <= (k) && (k) < hi)
#if MK_ONE_LAUNCH
#define SEAM(k) do { if ((k) != 3 && (k) != 6 && (k) != 9 && (k) != 11 && (k) != 14 && IN(k) && IN((k) + 1)) { xcd_barrier(bar); } } while (0)
#else
#define SEAM(k) do { } while (0)
#endif
    if (hi == 0x7fffffff) cg::this_grid().sync();
#define PHASE(k) do { if (IN(k)) { if (REPS(k) == 2) run_phase<k, true>(C, args); run_phase<k>(C, args); } SEAM(k); } while (0)
    PHASE(0);
    for (int xs_ = 0; xs_ < XSYNC; ++xs_) cg::this_grid().sync();
    PHASE(1); PHASE(2); PHASE(3); PHASE(4); PHASE(5); PHASE(6); PHASE(7); PHASE(8); PHASE(9); PHASE(10); PHASE(11); PHASE(12); PHASE(13); PHASE(14); PHASE(15);
#undef PHASE
#undef IN
#undef SEAM
}

extern "C" void kernel_launch(void* const* d_in, const int* in_sizes, int n_in, void* d_out, int out_size, void* d_ws, size_t ws_size, hipStream_t stream) {
    static int grid = 0;
    if (grid == 0) {
        int dev = 0, cus = 0, per_cu = 0;
        hipGetDevice(&dev); hipDeviceGetAttribute(&cus, hipDeviceAttributeMultiprocessorCount, dev);
        hipFuncSetAttribute((const void*)fwd_kernel, hipFuncAttributeMaxDynamicSharedMemorySize, LDS_BYTES);
        hipOccupancyMaxActiveBlocksPerMultiprocessor(&per_cu, (const void*)fwd_kernel, NTHR, LDS_BYTES);
        if (per_cu < 1) { fprintf(stderr, "kernel_launch: occupancy query says %d blocks/CU\n", per_cu); per_cu = 1; }
        (void)hipGetLastError();
        grid = cus * per_cu;
        if (n_in != 23 || ws_size < 256 * MiB) fprintf(stderr, "kernel_launch: unexpected n_in %d / ws %zu\n", n_in, ws_size);
    }
    (void)hipMemsetAsync((char*)d_ws + WS_BAR, 0, CTL_ZERO_BYTES, stream);
    Args a{};
    for (int i = 0; i < 23; ++i) a.in[i] = (const float*)d_in[i];
    a.out = (float*)d_out; a.ws = (unsigned char*)d_ws;
#if MK_ONE_LAUNCH
    a.ph_lo = 0; a.ph_hi = NPH;
    void* kargs[] = {&a};
    hipError_t e = hipLaunchCooperativeKernel((const void*)fwd_kernel, dim3(grid), dim3(NTHR), kargs, LDS_BYTES, stream);
    if (e != hipSuccess) fprintf(stderr, "cooperative launch failed: %s (grid %d)\n", hipGetErrorString(e), grid);
#else
    for (int p = 0; p < NPH; ++p) { a.ph_lo = p; a.ph_hi = p + 1; hipLaunchKernelGGL(fwd_kernel, dim3(grid), dim3(NTHR), LDS_BYTES, stream, a); }
#endif
}
```

```cpp
#include <hip/hip_runtime.h>
#include <hip/hip_cooperative_groups.h>
#include <cstdio>
#include <cstdint>
#include <cmath>
namespace cg = cooperative_groups;

#ifndef MK_ONE_LAUNCH
#define MK_ONE_LAUNCH 1
#endif

#define LAS __attribute__((address_space(3)))
typedef unsigned short bf16_t;
typedef short bf16x8 __attribute__((ext_vector_type(8)));
typedef float f32x4 __attribute__((ext_vector_type(4)));
typedef float f32x2 __attribute__((ext_vector_type(2)));
typedef unsigned u32x4 __attribute__((ext_vector_type(4)));
typedef unsigned u32x2 __attribute__((ext_vector_type(2)));

constexpr int D = 1024, MTP = 16384, MTS = 1024, MT = MTP + MTS, DG = 3072, DFF = 2816, SEQ = 2048;
constexpr float EPS = 1e-6f;
constexpr int NWAVES = 8, NTHR = 512;
constexpr int LDS_BYTES = 147456;
constexpr size_t O_Y = 0, O_PCONV = (size_t)MT * D, O_PH = O_PCONV + 8 * 3 * 1024, O_SCONV = O_PH + 8 * 1024, O_SH = O_SCONV + 128 * 3 * 1024, O_SV = O_SH + 128 * 1024;
constexpr size_t MiB = 1u << 20;
constexpr size_t WS_SP = 0;
constexpr size_t WS_BAR = 65536;
constexpr size_t WS_CNT = 262144;
constexpr size_t CNT_WORDS = (4 * 2 * 64 + 4 * 4) * 64;
constexpr size_t WS_FLG = WS_CNT + CNT_WORDS * 4;
constexpr size_t CTL_ZERO_BYTES = WS_FLG + 272 * 8 * 64 - WS_BAR;
static_assert(WS_FLG + 272 * 8 * 64 <= 1u << 20, "control region");
constexpr size_t WS_RSTD = 131072;
constexpr size_t WS_ST = 1 * MiB;
constexpr size_t WS_WG3 = 5 * MiB;
constexpr size_t WS_WF1 = 11 * MiB;
constexpr size_t WS_WF2 = 22 * MiB;
constexpr size_t WS_WF1B = WS_WF2 + 5632 * 1024;
constexpr size_t WS_WF2B = WS_WF1B + 11 * MiB;
constexpr size_t WS_WR1 = 44 * MiB;
constexpr size_t WS_WR2 = 48 * MiB;
constexpr size_t WS_WAX = 50 * MiB;
constexpr size_t WS_WSB = WS_WAX + 512 * 1024;
constexpr size_t WS_TS = WS_ST;
constexpr size_t WS_U = 52 * MiB;
constexpr size_t WS_V = 154 * MiB;
constexpr size_t DO_HN = 0, DO_WG1 = 36 * MiB;
static_assert((size_t)MT * D * 2 <= DO_WG1 && DO_WG1 + (size_t)6144 * 1024 * 2 <= (size_t)MT * D * 4, "d_out scratch");
static_assert(WS_TS + (size_t)272 * 1024 * 8 <= WS_WG3 && WS_WSB + 8 * 128 * 128 * 2 <= WS_U, "ts");
static_assert(WS_U + (size_t)MT * DG * 2 <= WS_V, "U region");
static_assert(WS_V + (size_t)MT * DG * 2 <= 256 * MiB, "V region");
static_assert(WS_ST + (size_t)24 * MT * 8 <= WS_WG3, "stats");

namespace pg8 {
constexpr int BM = 256, BK = 64, HALF = 128, HTB = HALF * BK * 2, STAGE_BYTES = 8 * HTB, NXCD = 8, WGM = 8;
__host__ __device__ __forceinline__ int lds_byte(int r, int c) { const int st = (r >> 4) * 2 + (c >> 5), rr = r & 15, cc = c & 31, ob = rr * 64 + cc * 2; return st * 1024 + (ob ^ (((ob >> 9) & 1) << 5)); }
__host__ __device__ __forceinline__ void stage_rc(int b, int& R, int& C) { const int st = b / 1024, sb = b % 1024, swz = sb ^ (((sb >> 9) & 1) << 5); R = (st >> 1) * 16 + swz / 64; C = (st & 1) * 32 + (swz % 64) / 2; }
__host__ __device__ __forceinline__ int perm32(int rho) { const int n = rho >> 4, i = rho & 15; return 8 * (i >> 2) + 4 * n + (i & 3); }

struct Unit { const char* a; const char* b; int pm, pn, kind, nt, ks; };
struct Sched {
    const char *A0, *B0, *A1, *B1; int nM0, nN0, nM1, nN1, n0, nwg, G, c, ntF; size_t tstep;
    __device__ __forceinline__ void init(const void* a0, const void* b0, int M0, int N0, const void* a1, const void* b1, int M1, int N1, int K, int G_, int c_) {
        A0 = (const char*)a0; B0 = (const char*)b0; A1 = (const char*)a1; B1 = (const char*)b1; nM0 = M0 / BM; nN0 = N0 / BM; nM1 = M1 / BM; nN1 = N1 / BM;
        n0 = nM0 * nN0; nwg = n0 + nM1 * nN1; G = G_; c = c_; ntF = K / BK; tstep = (size_t)BM * K * 2; }
    __device__ __forceinline__ bool next(int i, Unit& u) const {
        const long L = (long)i * G + c; if (L >= nwg) return false;
        int wgid = (int)L; { const int q = nwg / NXCD, r = nwg % NXCD, xcd = wgid % NXCD, off = wgid / NXCD; wgid = (xcd < r ? xcd * (q + 1) : r * (q + 1) + (xcd - r) * q) + off; }
        int kind = 0, nM = nM0, nN = nN0; const char* A = A0; const char* B = B0;
        if (wgid >= n0) { wgid -= n0; kind = 1; nM = nM1; nN = nN1; A = A1; B = B1; }
        const int nig = WGM * nN, gid = wgid / nig, fm = gid * WGM, gsz = (nM - fm) < WGM ? (nM - fm) : WGM;
        u.pm = fm + ((wgid % nig) % gsz); u.pn = (wgid % nig) / gsz; u.kind = kind; u.nt = ntF; u.ks = 0; u.a = A + (size_t)u.pm * tstep; u.b = B + (size_t)u.pn * tstep; return true;
    }
};
struct SchedTail {
    const char *A, *B; int G, c, ntF, NS; size_t tstep;
    __device__ __forceinline__ void init(const void* a, const void* b, int K, int NS_, int G_, int c_) { A = (const char*)a; B = (const char*)b; G = G_; c = c_; ntF = K / BK; NS = NS_; tstep = (size_t)BM * K * 2; }
    __device__ __forceinline__ bool next(int i, Unit& u) const {
        const bool has_sub = c < 16 * NS; const int ip = has_sub ? i - 1 : i, L = ip * G + c;
        if (ip >= 0) { if (L >= 256) return false;
            u.pm = 8 * (L & 7) + ((L >> 3) & 7); u.pn = L >> 6; u.kind = 0; u.nt = ntF; u.ks = 0; u.a = A + (size_t)u.pm * tstep; u.b = B + (size_t)u.pn * tstep; return true; }
        const int r = c;
        const int ks = r % NS, t = r / NS, hp = ntF >> 1, p0 = ks * hp / NS, p1 = (ks + 1) * hp / NS;
        u.pm = 64 + (t >> 2); u.pn = t & 3; u.kind = 1; u.ks = ks; u.nt = 2 * (p1 - p0);
        u.a = A + (size_t)u.pm * tstep + (size_t)p0 * (4 * BK); u.b = B + (size_t)u.pn * tstep + (size_t)p0 * (4 * BK); return true;
    }
};

__device__ __forceinline__ unsigned cvt_pk_bf16(float lo, float hi) { unsigned r; asm volatile("v_cvt_pk_bf16_f32 %0, %1, %2" : "=v"(r) : "v"(lo), "v"(hi)); return r; }
__device__ __forceinline__ float gelu_t(float x) {
    const float y = x * (1.0f + 0.044715f * x * x) * (-1.5957691216f * 1.4426950409f);
    return x * __builtin_amdgcn_rcpf(1.0f + __builtin_amdgcn_exp2f(y));
}
__device__ __forceinline__ float sigmoid_f(float x) { return __builtin_amdgcn_rcpf(1.0f + __builtin_amdgcn_exp2f(x * -1.4426950409f)); }
__device__ __forceinline__ f32x2 gelu2(f32x2 x) {
    const f32x2 t = (x * x) * (0.044715f * -1.5957691216f * 1.4426950409f) + (-1.5957691216f * 1.4426950409f), y = x * t;
    f32x2 e; e.x = __builtin_amdgcn_exp2f(y.x); e.y = __builtin_amdgcn_exp2f(y.y);
    const f32x2 d = e + 1.0f; f32x2 r; r.x = __builtin_amdgcn_rcpf(d.x); r.y = __builtin_amdgcn_rcpf(d.y);
    return x * r;
}
__device__ __forceinline__ f32x2 silu_mul2(f32x2 g, f32x2 u) {
    const f32x2 y = g * -1.4426950409f; f32x2 e; e.x = __builtin_amdgcn_exp2f(y.x); e.y = __builtin_amdgcn_exp2f(y.y);
    const f32x2 d = e + 1.0f; f32x2 r; r.x = __builtin_amdgcn_rcpf(d.x); r.y = __builtin_amdgcn_rcpf(d.y);
    return (g * r) * u;
}
__device__ __forceinline__ float rstd16(const float* p4) {
    const f32x4 t = *(const f32x4*)p4; return __builtin_amdgcn_rsqf(((t[0] + t[1]) + (t[2] + t[3])) * (1.f / D) + EPS); }
__device__ __forceinline__ f32x4 gelu4s(f32x4 v) { return (f32x4){gelu_t(v[0]), gelu_t(v[1]), gelu_t(v[2]), gelu_t(v[3])}; }
__device__ __forceinline__ f32x4 gelu4(f32x4 v) { const f32x2 a = gelu2((f32x2){v[0], v[1]}), b = gelu2((f32x2){v[2], v[3]}); return (f32x4){a.x, a.y, b.x, b.y}; }

template <int ACT> __device__ __forceinline__ void store_tile_bf16(const f32x4 (&acc)[2][2][4][2], int pm, int coltile, bf16_t* O, int ldc, const float* bias  , int wr, int wc, int fr, int fq, const float* rs = nullptr  , bool rs16 = false  ) {
    const int row0 = pm * BM + wr * 64 + fr, col0 = coltile + wc * 32 + 8 * fq;
    f32x4 bv[2][2];
#pragma unroll
    for (int bj = 0; bj < 2; ++bj)
#pragma unroll
        for (int n = 0; n < 2; ++n) bv[bj][n] = bias ? *(const f32x4*)(bias + wc * 32 + 8 * fq + bj * HALF + 4 * n) : (f32x4){0.f, 0.f, 0.f, 0.f};
#pragma unroll
    for (int ai = 0; ai < 2; ++ai)
#pragma unroll
        for (int m = 0; m < 4; ++m) { bf16_t* rowp = O + (size_t)(row0 + ai * HALF + m * 16) * ldc + col0; const float rsv = rs ? (rs16 ? rstd16(rs + (size_t)(row0 + ai * HALF + m * 16) * 4) : rs[row0 + ai * HALF + m * 16]) : 1.0f;
#pragma unroll
            for (int bj = 0; bj < 2; ++bj) { f32x4 v0 = acc[ai][bj][m][0] * rsv + bv[bj][0], v1 = acc[ai][bj][m][1] * rsv + bv[bj][1];
                if (ACT == 1) { v0 = gelu4s(v0); v1 = gelu4s(v1); }
                if (ACT == 2) { v0 = gelu4(v0); v1 = gelu4(v1); }
                u32x4 w; w.x = cvt_pk_bf16(v0[0], v0[1]); w.y = cvt_pk_bf16(v0[2], v0[3]); w.z = cvt_pk_bf16(v1[0], v1[1]); w.w = cvt_pk_bf16(v1[2], v1[3]);
                *(u32x4*)(rowp + bj * HALF) = w; } }
}

struct EpiPlain {
    bf16_t* O; int ldc;
    __device__ __forceinline__ void operator()(const f32x4 (&acc)[2][2][4][2], const Unit& u, int wr, int wc, int fr, int fq) const { store_tile_bf16<0>(acc, u.pm, u.pn * BM, O, ldc, nullptr, wr, wc, fr, fq); }
};
struct EpiTail {
    bf16_t* O; float* PB;
    __device__ __forceinline__ void operator()(const f32x4 (&acc)[2][2][4][2], const Unit& u, int wr, int wc, int fr, int fq) const {
        if (u.kind == 0) { store_tile_bf16<0>(acc, u.pm, u.pn * BM, O, D, nullptr, wr, wc, fr, fq); return; }
        float* base = PB + (size_t)u.ks * (MTS * D) + (size_t)((u.pm - 64) * BM + wr * 64 + fr) * D + u.pn * BM + wc * 32 + 8 * fq;
#pragma unroll
        for (int ai = 0; ai < 2; ++ai)
#pragma unroll
            for (int m = 0; m < 4; ++m)
#pragma unroll
                for (int bj = 0; bj < 2; ++bj) { float* p = base + (size_t)(ai * HALF + m * 16) * D + bj * HALF; *(f32x4*)p = acc[ai][bj][m][0]; *(f32x4*)(p + 4) = acc[ai][bj][m][1]; }
    }
};
struct RmsExchange {
    float* xbuf; unsigned* cnt;
    __device__ __forceinline__ void publish(const f32x4 (&v)[2][2][4][2], int pm, int pn, int wr, int wc, int fr, int fq, LAS unsigned char* lds) const {
        LAS float* P = (LAS float*)lds;
        const int wid = wr * 4 + wc, lane = fq * 16 + fr;
#pragma unroll
        for (int ai = 0; ai < 2; ++ai)
#pragma unroll
            for (int m = 0; m < 4; ++m) { float s = 0.f;
#pragma unroll
                for (int bj = 0; bj < 2; ++bj)
#pragma unroll
                    for (int n = 0; n < 2; ++n) { const f32x4 x = v[ai][bj][m][n]; s += (x[0] * x[0] + x[1] * x[1]) + (x[2] * x[2] + x[3] * x[3]); }
                s += __shfl_xor(s, 16); s += __shfl_xor(s, 32);
                if (fq == 0) P[(ai * HALF + wr * 64 + m * 16 + fr) * 4 + wc] = s; }
        asm volatile("s_waitcnt lgkmcnt(0)" ::: "memory"); __builtin_amdgcn_s_barrier(); asm volatile("" ::: "memory");
        const int row = wid * 32 + (lane & 31);
        if (lane < 32) { const float t = (P[row * 4 + 0] + P[row * 4 + 1]) + (P[row * 4 + 2] + P[row * 4 + 3]);
            __hip_atomic_store(xbuf + ((size_t)(pm * BM + row) * 4 + pn), t, __ATOMIC_RELAXED, __HIP_MEMORY_SCOPE_AGENT); }
        asm volatile("s_waitcnt vmcnt(0)" ::: "memory");
        if (lane == 0) __hip_atomic_fetch_add(cnt + 64 * pm, 1u, __ATOMIC_RELAXED, __HIP_MEMORY_SCOPE_AGENT);
    }
    __device__ __forceinline__ void wait(int pm, int pn, int wr, int wc, int fr, int fq, LAS unsigned char* lds, float* rstd_out  ) const {
        LAS float* S = (LAS float*)(lds + 4096);
        const int wid = wr * 4 + wc, lane = fq * 16 + fr, row = wid * 32 + (lane & 31);
        if (wid == 0) { unsigned sp = 0;
            while ((unsigned)__builtin_amdgcn_readfirstlane(__hip_atomic_load(cnt + 64 * pm, __ATOMIC_RELAXED, __HIP_MEMORY_SCOPE_AGENT)) < 32u) { __builtin_amdgcn_s_sleep(2); if (++sp > (1u << 22)) break; }
            __builtin_amdgcn_fence(__ATOMIC_ACQUIRE, "agent"); }
        asm volatile("s_waitcnt vmcnt(0) lgkmcnt(0)" ::: "memory"); __builtin_amdgcn_s_barrier(); asm volatile("" ::: "memory");
        if (lane < 32) { const float* slot = xbuf + (size_t)(pm * BM + row) * 4; float t = 0.f;
#pragma unroll
            for (int k = 0; k < 4; ++k) t += __hip_atomic_load(slot + k, __ATOMIC_RELAXED, __HIP_MEMORY_SCOPE_AGENT);
            const float rs = __builtin_amdgcn_rsqf(t * (1.f / D) + EPS); S[row] = rs;
            if (rstd_out && pn == 0) rstd_out[pm * BM + row] = rs; }
        asm volatile("s_waitcnt lgkmcnt(0)" ::: "memory"); __builtin_amdgcn_s_barrier(); asm volatile("" ::: "memory");
    }
};
template <bool FINAL> struct EpiTailFused {
    bf16_t* PB; unsigned* scnt  ; RmsExchange e1; const bf16_t* XBin  ; bf16_t* XB  ; const float* g1; float* outf; float* RSTD  ; LAS unsigned char* ldsx;
    static __device__ __forceinline__ void unpack8(f32x4& a, f32x4& b, u32x4 w) {
        a = (f32x4){__builtin_bit_cast(float, w.x << 16), __builtin_bit_cast(float, w.x & 0xffff0000u), __builtin_bit_cast(float, w.y << 16), __builtin_bit_cast(float, w.y & 0xffff0000u)};
        b = (f32x4){__builtin_bit_cast(float, w.z << 16), __builtin_bit_cast(float, w.z & 0xffff0000u), __builtin_bit_cast(float, w.w << 16), __builtin_bit_cast(float, w.w & 0xffff0000u)}; }
    __device__ __forceinline__ void operator()(f32x4 (&acc)[2][2][4][2], const Unit& u, int wr, int wc, int fr, int fq) const {
        if (u.kind == 1) {
            bf16_t* base = PB + (size_t)u.ks * (MTS * D) + (size_t)((u.pm - 64) * BM + wr * 64 + fr) * D + u.pn * BM + wc * 32 + 8 * fq;
#pragma unroll
            for (int ai = 0; ai < 2; ++ai)
#pragma unroll
                for (int m = 0; m < 4; ++m)
#pragma unroll
                    for (int bj = 0; bj < 2; ++bj) { const f32x4 v0 = acc[ai][bj][m][0], v1 = acc[ai][bj][m][1]; u32x4 w; w.x = cvt_pk_bf16(v0[0], v0[1]); w.y = cvt_pk_bf16(v0[2], v0[3]); w.z = cvt_pk_bf16(v1[0], v1[1]); w.w = cvt_pk_bf16(v1[2], v1[3]);
                        *(u32x4*)(base + (size_t)(ai * HALF + m * 16) * D + bj * HALF) = w; }
            asm volatile("s_waitcnt vmcnt(0)" ::: "memory"); __builtin_amdgcn_s_barrier(); asm volatile("" ::: "memory");
            if (threadIdx.x == 0) { __builtin_amdgcn_fence(__ATOMIC_RELEASE, "agent"); asm volatile("s_waitcnt vmcnt(0)" ::: "memory");
                __hip_atomic_fetch_add(scnt + 64 * (u.pm - 64), 1u, __ATOMIC_RELAXED, __HIP_MEMORY_SCOPE_AGENT); }
            return; }
        const LAS float* S = (const LAS float*)(ldsx + 4096);
        const int col0 = u.pn * BM + wc * 32 + 8 * fq;
        e1.publish(acc, u.pm, u.pn, wr, wc, fr, fq, ldsx);
        u32x4 pre[4][2];
#pragma unroll
        for (int m = 0; m < 4; ++m)
#pragma unroll
            for (int bj = 0; bj < 2; ++bj) pre[m][bj] = *(const u32x4*)(XBin + (size_t)(u.pm * BM + wr * 64 + m * 16 + fr) * D + col0 + bj * HALF);
        f32x4 gv[2][2];
#pragma unroll
        for (int bj = 0; bj < 2; ++bj)
#pragma unroll
            for (int n = 0; n < 2; ++n) gv[bj][n] = *(const f32x4*)(g1 + col0 + bj * HALF + 4 * n);
        e1.wait(u.pm, u.pn, wr, wc, fr, fq, ldsx, nullptr);
#pragma unroll
        for (int ai = 0; ai < 2; ++ai)
#pragma unroll
            for (int m = 0; m < 4; ++m) { const int row = ai * HALF + wr * 64 + m * 16 + fr; const float rs = S[row]; const size_t off = (size_t)(u.pm * BM + row) * D + col0; float s2 = 0.f;
#pragma unroll
                for (int bj = 0; bj < 2; ++bj) { f32x4 x0, x1; unpack8(x0, x1, ai == 0 ? pre[m][bj] : *(const u32x4*)(XBin + off + bj * HALF));
                    const f32x4 v0 = x0 + acc[ai][bj][m][0] * rs * gv[bj][0], v1 = x1 + acc[ai][bj][m][1] * rs * gv[bj][1];
                    s2 += ((v0[0] * v0[0] + v0[1] * v0[1]) + (v0[2] * v0[2] + v0[3] * v0[3])) + ((v1[0] * v1[0] + v1[1] * v1[1]) + (v1[2] * v1[2] + v1[3] * v1[3]));
                    if (FINAL) { *(f32x4*)(outf + off + bj * HALF) = v0; *(f32x4*)(outf + off + bj * HALF + 4) = v1; }
                    else { u32x4 w; w.x = cvt_pk_bf16(v0[0], v0[1]); w.y = cvt_pk_bf16(v0[2], v0[3]); w.z = cvt_pk_bf16(v1[0], v1[1]); w.w = cvt_pk_bf16(v1[2], v1[3]); *(u32x4*)(XB + off + bj * HALF) = w; } }
                if (!FINAL) { s2 += __shfl_xor(s2, 16); s2 += __shfl_xor(s2, 32);
                    if (fq == 0) ((LAS float*)ldsx)[row * 4 + wc] = s2; }
                if (m == 3) asm volatile("" ::: "memory"); }
        if (!FINAL) {
            asm volatile("s_waitcnt lgkmcnt(0)" ::: "memory"); __builtin_amdgcn_s_barrier(); asm volatile("" ::: "memory");
            const int wid = wr * 4 + wc, lane = fq * 16 + fr, row = wid * 32 + (lane & 31); const LAS float* P = (const LAS float*)ldsx;
            if (lane < 32) RSTD[(size_t)(u.pm * BM + row) * 4 + u.pn] = (P[row * 4 + 0] + P[row * 4 + 1]) + (P[row * 4 + 2] + P[row * 4 + 3]);
            asm volatile("s_waitcnt lgkmcnt(0)" ::: "memory"); __builtin_amdgcn_s_barrier(); asm volatile("" ::: "memory");
        }
    }
};
struct EpiG6 {
    bf16_t* GATE; bf16_t* XBR; const float* rs;
    __device__ __forceinline__ void operator()(const f32x4 (&acc)[2][2][4][2], const Unit& u, int wr, int wc, int fr, int fq) const {
        if (u.pn < 4) store_tile_bf16<2>(acc, u.pm, u.pn * BM, GATE, D, nullptr, wr, wc, fr, fq, rs, true);
        else store_tile_bf16<0>(acc, u.pm, (u.pn - 4) * BM, XBR, D, nullptr, wr, wc, fr, fq, rs, true);
    }
};
struct EpiSwiglu {
    bf16_t* H; const float* rs;
    __device__ __forceinline__ void operator()(const f32x4 (&acc)[2][2][4][2], const Unit& u, int wr, int wc, int fr, int fq) const {
        const int row0 = u.pm * BM + wr * 64 + fr, col0 = u.pn * HALF + wc * 32 + 8 * fq;
#pragma unroll
        for (int ai = 0; ai < 2; ++ai)
#pragma unroll
            for (int m = 0; m < 4; ++m) { bf16_t* rowp = H + (size_t)(row0 + ai * HALF + m * 16) * DFF + col0; f32x4 o[2]; const float rsv = rstd16(rs + (size_t)(row0 + ai * HALF + m * 16) * 4);
#pragma unroll
                for (int n = 0; n < 2; ++n) { const f32x4 g = acc[ai][0][m][n] * rsv, uu = acc[ai][1][m][n] * rsv;
                    const f32x2 a = silu_mul2((f32x2){g[0], g[1]}, (f32x2){uu[0], uu[1]}), b = silu_mul2((f32x2){g[2], g[3]}, (f32x2){uu[2], uu[3]}); o[n] = (f32x4){a.x, a.y, b.x, b.y}; }
                u32x4 w; w.x = cvt_pk_bf16(o[0][0], o[0][1]); w.y = cvt_pk_bf16(o[0][2], o[0][3]); w.z = cvt_pk_bf16(o[1][0], o[1][1]); w.w = cvt_pk_bf16(o[1][2], o[1][3]);
                *(u32x4*)rowp = w; }
    }
};
__device__ __forceinline__ float row16_sum_lane0(float v) {
    v += __builtin_bit_cast(float, __builtin_amdgcn_update_dpp(0, __builtin_bit_cast(int, v), 0x108, 0xf, 0xf, true));
    v += __builtin_bit_cast(float, __builtin_amdgcn_update_dpp(0, __builtin_bit_cast(int, v), 0x104, 0xf, 0xf, true));
    v += __builtin_bit_cast(float, __builtin_amdgcn_update_dpp(0, __builtin_bit_cast(int, v), 0x102, 0xf, 0xf, true));
    v += __builtin_bit_cast(float, __builtin_amdgcn_update_dpp(0, __builtin_bit_cast(int, v), 0x101, 0xf, 0xf, true));
    return v;
}
struct EpiG1 {
    bf16_t* U; bf16_t* VT; const float* b_in; f32x2* ST; const float* rs;
    __device__ __forceinline__ void operator()(const f32x4 (&acc)[2][2][4][2], const Unit& u, int wr, int wc, int fr, int fq) const {
        if (u.kind == 0) { store_tile_bf16<2>(acc, u.pm, u.pn * BM, U, DG, b_in + u.pn * BM, wr, wc, fr, fq, rs); return; }
        const int row0 = u.pm * BM + wr * 64 + fr, col0 = u.pn * BM + wc * 32 + 8 * fq;
#pragma unroll
        for (int bj = 0; bj < 2; ++bj) {
            float cs[2][4], cq[2][4]; const f32x4 rc0 = *(const f32x4*)(rs + col0 + bj * HALF), rc1 = *(const f32x4*)(rs + col0 + bj * HALF + 4);
#pragma unroll
            for (int n = 0; n < 2; ++n)
#pragma unroll
                for (int j = 0; j < 4; ++j) { cs[n][j] = 0.f; cq[n][j] = 0.f; }
#pragma unroll
            for (int ai = 0; ai < 2; ++ai)
#pragma unroll
                for (int m = 0; m < 4; ++m) { const int row = row0 + ai * HALF + m * 16; const float bv = b_in[DG + row]; bf16_t* rowp = VT + (size_t)row * MT + col0 + bj * HALF;
                    { const f32x4 v0 = gelu4s(acc[ai][bj][m][0] * rc0 + bv);
#pragma unroll
                      for (int j = 0; j < 4; ++j) { cs[0][j] += v0[j]; cq[0][j] += v0[j] * v0[j]; }
                      u32x2 w; w.x = cvt_pk_bf16(v0[0], v0[1]); w.y = cvt_pk_bf16(v0[2], v0[3]); *(u32x2*)rowp = w; }
                    { const f32x4 v1 = gelu4s(acc[ai][bj][m][1] * rc1 + bv);
#pragma unroll
                      for (int j = 0; j < 4; ++j) { cs[1][j] += v1[j]; cq[1][j] += v1[j] * v1[j]; }
                      u32x2 w; w.x = cvt_pk_bf16(v1[0], v1[1]); w.y = cvt_pk_bf16(v1[2], v1[3]); *(u32x2*)(rowp + 4) = w; } }
#pragma unroll
            for (int n = 0; n < 2; ++n) {
#pragma unroll
                for (int j = 0; j < 4; ++j) { cs[n][j] = row16_sum_lane0(cs[n][j]); cq[n][j] = row16_sum_lane0(cq[n][j]); }
                if (fr == 0) { f32x2* sp = ST + (size_t)(u.pm * 2 + wr) * MT + col0 + bj * HALF + 4 * n;
                    *(f32x4*)(sp) = (f32x4){cs[n][0], cq[n][0], cs[n][1], cq[n][1]};
                    *(f32x4*)(sp + 2) = (f32x4){cs[n][2], cq[n][2], cs[n][3], cq[n][3]}; } }
            asm volatile("" ::: "memory");
        }
    }
};

template <class Epi, class SchedT>
__device__ __forceinline__ void gemm_phase(LAS unsigned char* lds, const int K, const SchedT& S, const Epi& E) {
    const int tid = threadIdx.x, wid = __builtin_amdgcn_readfirstlane(tid >> 6), lane = tid & 63, wr = wid >> 2, wc = wid & 3, fr = lane & 15, fq = lane >> 4;
    unsigned voffA[2], voffB[2];
#pragma unroll
    for (int i = 0; i < 2; ++i) { int R, C; stage_rc(tid * 16 + i * 8192, R, C); const int Rb = (R & ~31) + perm32(R & 31);
        voffA[i] = (unsigned)(R * K + C) * 2u; voffB[i] = (unsigned)(Rb * K + C) * 2u; }
    const size_t kstep = (size_t)(BK * 2);
    const size_t hstep = (size_t)HALF * K * 2;
    const unsigned ldsw = (unsigned)wid * 1024u;
    const int aoff = lds_byte(wr * 64 + fr, fq * 8), boff = lds_byte(wc * 32 + fr, fq * 8);
#define PG8_SA(b, h) (((b) * 2 + (h)) * HTB)
#define PG8_SB(b, h) ((4 + (b) * 2 + (h)) * HTB)
#define PG8_STAGE(bufoff, gbase, voff) do { _Pragma("unroll") for (int _i = 0; _i < 2; ++_i) \
        __builtin_amdgcn_global_load_lds((const unsigned*)((const char*)(gbase) + (voff)[_i]), (LAS unsigned*)(lds + (bufoff) + ldsw + _i * 8192), 16, 0, 0); } while (0)
#define PG8_LDA(dst, b, h) do { _Pragma("unroll") for (int m = 0; m < 4; ++m) _Pragma("unroll") for (int k = 0; k < 2; ++k) dst[m][k] = *(const LAS bf16x8*)(lds + PG8_SA(b, h) + aoff + m * 2048 + k * 1024); } while (0)
#define PG8_LDB(dst, b, h) do { _Pragma("unroll") for (int n = 0; n < 2; ++n) _Pragma("unroll") for (int k = 0; k < 2; ++k) dst[n][k] = *(const LAS bf16x8*)(lds + PG8_SB(b, h) + boff + n * 2048 + k * 1024); } while (0)
#define PG8_MMA(ai, bj, At, Bt) do { __builtin_amdgcn_s_setprio(1); _Pragma("unroll") for (int m = 0; m < 4; ++m) _Pragma("unroll") for (int n = 0; n < 2; ++n) _Pragma("unroll") for (int k = 0; k < 2; ++k) \
        acc[ai][bj][m][n] = __builtin_amdgcn_mfma_f32_16x16x32_bf16(Bt[n][k], At[m][k], acc[ai][bj][m][n], 0, 0, 0); __builtin_amdgcn_s_setprio(0); } while (0)
#define PG8_WAIT_V(n) asm volatile("s_waitcnt vmcnt(" #n ")" ::: "memory")
#define PG8_WAIT_L(n) asm volatile("s_waitcnt lgkmcnt(" #n ")" ::: "memory")
#define PG8_BAR __builtin_amdgcn_s_barrier()
#define PG8_SCHED __builtin_amdgcn_sched_barrier(0)
    Unit cur, nxt; int ui = 0;
    if (!S.next(0, cur)) return;
    f32x4 acc[2][2][4][2];
#pragma unroll
    for (int a = 0; a < 2; ++a)
#pragma unroll
        for (int b = 0; b < 2; ++b)
#pragma unroll
            for (int m = 0; m < 4; ++m)
#pragma unroll
                for (int n = 0; n < 2; ++n) acc[a][b][m][n] = (f32x4){0.f, 0.f, 0.f, 0.f};
    bf16x8 At[4][2], B0[2][2], B1[2][2];
    const char* cA = cur.a; const char* cB = cur.b;
    PG8_WAIT_V(0);
    PG8_STAGE(PG8_SB(0, 0), cB, voffB); PG8_STAGE(PG8_SB(0, 1), cB + hstep, voffB); PG8_STAGE(PG8_SA(0, 0), cA, voffA); PG8_STAGE(PG8_SA(0, 1), cA + hstep, voffA);
    if (wr == 1) PG8_BAR;
    PG8_WAIT_V(2); PG8_BAR;
    PG8_STAGE(PG8_SB(1, 0), cB + kstep, voffB); PG8_STAGE(PG8_SA(1, 0), cA + kstep, voffA); PG8_STAGE(PG8_SB(1, 1), cB + hstep + kstep, voffB);
    PG8_WAIT_V(6); PG8_BAR;
    for (;;) {
        const bool has_next = S.next(ui + 1, nxt); const int nt = cur.nt;
        const char* nA = has_next ? nxt.a : cA; const char* nB = has_next ? nxt.b : cB;
        for (int t = 0; t < nt; t += 2) {
            const bool last = (t == nt - 2);
            const char* a1 = cA + (size_t)(t + 1) * kstep;
            const char* a2 = last ? nA : cA + (size_t)(t + 2) * kstep; const char* b2 = last ? nB : cB + (size_t)(t + 2) * kstep;
            const char* a3 = a2 + kstep; const char* b3 = b2 + kstep;
            PG8_LDB(B0, 0, 0); PG8_LDB(B1, 0, 1); PG8_SCHED; PG8_LDA(At, 0, 0); PG8_STAGE(PG8_SA(1, 1), a1 + hstep, voffA);
            PG8_WAIT_V(8); PG8_WAIT_L(0); PG8_BAR; PG8_MMA(0, 0, At, B0); PG8_MMA(0, 1, At, B1); PG8_BAR; PG8_SCHED;
            PG8_LDA(At, 0, 1); PG8_STAGE(PG8_SB(0, 0), b2, voffB); PG8_STAGE(PG8_SB(0, 1), b2 + hstep, voffB); PG8_STAGE(PG8_SA(0, 0), a2, voffA);
            PG8_WAIT_V(8); PG8_WAIT_L(0); PG8_BAR; PG8_MMA(1, 0, At, B0); PG8_MMA(1, 1, At, B1); PG8_BAR; PG8_SCHED;
            PG8_LDB(B0, 1, 0); PG8_LDB(B1, 1, 1); PG8_SCHED; PG8_LDA(At, 1, 0); PG8_STAGE(PG8_SA(0, 1), a2 + hstep, voffA);
            PG8_WAIT_V(8); PG8_WAIT_L(0); PG8_BAR; PG8_MMA(0, 0, At, B0); PG8_MMA(0, 1, At, B1); PG8_BAR; PG8_SCHED;
            PG8_LDA(At, 1, 1); PG8_STAGE(PG8_SB(1, 0), b3, voffB); PG8_STAGE(PG8_SB(1, 1), b3 + hstep, voffB); PG8_STAGE(PG8_SA(1, 0), a3, voffA);
            PG8_WAIT_V(8); PG8_WAIT_L(0); PG8_BAR; PG8_MMA(1, 0, At, B0); PG8_MMA(1, 1, At, B1); PG8_BAR; PG8_SCHED;
        }
        if (wr == 0) PG8_BAR;
        E(acc, cur, wr, wc, fr, fq);
        if (!has_next) break;
#pragma unroll
        for (int a = 0; a < 2; ++a)
#pragma unroll
            for (int b = 0; b < 2; ++b)
#pragma unroll
                for (int m = 0; m < 4; ++m)
#pragma unroll
                    for (int n = 0; n < 2; ++n) acc[a][b][m][n] = (f32x4){0.f, 0.f, 0.f, 0.f};
        cur = nxt; cA = nA; cB = nB; ++ui;
        if (wr == 1) PG8_BAR;
    }
    PG8_WAIT_V(0);
    PG8_BAR;
#undef PG8_SA
#undef PG8_SB
#undef PG8_STAGE
#undef PG8_LDA
#undef PG8_LDB
#undef PG8_MMA
#undef PG8_WAIT_V
#undef PG8_WAIT_L
#undef PG8_BAR
#undef PG8_SCHED
}
}

#define LDS_WAIT() asm volatile("s_waitcnt lgkmcnt(0)" ::: "memory")
__device__ __forceinline__ unsigned f2bf(float f) { unsigned u = __builtin_bit_cast(unsigned, f); return (u + 0x7fffu + ((u >> 16) & 1u)) >> 16; }
__device__ __forceinline__ unsigned pk2(float lo, float hi) { return pg8::cvt_pk_bf16(lo, hi); }
__device__ __forceinline__ bf16_t f2bf1(float f) { return (bf16_t)(pg8::cvt_pk_bf16(f, f) & 0xffffu); }
__device__ __forceinline__ float bflo(unsigned w) { return __builtin_bit_cast(float, w << 16); }
__device__ __forceinline__ float bfhi(unsigned w) { return __builtin_bit_cast(float, w & 0xffff0000u); }
__device__ __forceinline__ float wave_sum(float v) {
#pragma unroll
    for (int o = 1; o < 64; o <<= 1) v += __shfl_xor(v, o);
    return v;
}

#define XB_TMO      128
#define XB_XCNT(j)  (256  + 64 * (j))
#define XB_XSUB(j)  (1280 + 64 * (j))
#define XB_XGEN(j)  (2304 + 64 * (j))
#define XB_TOP      3328
#define XB_TOPGEN   3392
#define XCD_BAR_WORDS 3456
#define XB_SPIN_CAP (1u << 18)

__device__ __forceinline__ unsigned xb_ld(unsigned* p)              { return __hip_atomic_load(p, __ATOMIC_RELAXED, __HIP_MEMORY_SCOPE_AGENT); }
__device__ __forceinline__ unsigned xb_add(unsigned* p, unsigned v) { return __hip_atomic_fetch_add(p, v, __ATOMIC_RELAXED, __HIP_MEMORY_SCOPE_AGENT); }
__device__ __forceinline__ unsigned xb_xcc_id() { return (unsigned)__builtin_amdgcn_s_getreg((3 << 11) | 20) & 0xFu; }
#define XB_SPIN(cond, bar) do { unsigned _sp = 0; while (cond) { __builtin_amdgcn_s_sleep(1); \
    if ((++_sp & 255u) == 0u) { if (xb_ld(&(bar)[XB_TMO])) break; if (_sp > XB_SPIN_CAP) { atomicAdd(&(bar)[XB_TMO], 1u); break; } } } } while (0)

struct XcdBarrier {
    unsigned* bar; unsigned x;
    volatile LAS unsigned* st;
};

__device__ __forceinline__ XcdBarrier xcd_barrier_post(unsigned* bar, volatile LAS unsigned* st) {
    XcdBarrier b; b.bar = bar; b.x = xb_xcc_id(); b.st = st;
    if (threadIdx.x == 0) (void)xb_add(&bar[XB_XCNT(b.x)], 1u);
    return b;
}
__device__ __forceinline__ void xcd_barrier_complete(unsigned* bar, unsigned x, unsigned& nloc, unsigned& nx) {
    const unsigned G = gridDim.x * gridDim.y * gridDim.z;
    unsigned sum, cnt, mine, sp = 0u;
    for (;;) {
        sum = 0u; cnt = 0u; mine = 0u;
#pragma unroll
        for (unsigned j = 0; j < 16; ++j) { const unsigned c = xb_ld(&bar[XB_XCNT(j)]); sum += c; cnt += (c > 0u) ? 1u : 0u; mine = (j == x) ? c : mine; }
        if (sum == G) break;
        __builtin_amdgcn_s_sleep(1);
        if ((++sp & 255u) == 0u) { if (xb_ld(&bar[XB_TMO])) break; if (sp > XB_SPIN_CAP) { atomicAdd(&bar[XB_TMO], 1u); break; } }
    }
    nloc = mine > 0u ? mine : 1u; nx = cnt > 0u ? cnt : 1u;
}

__device__ __forceinline__ void xcd_barrier(const XcdBarrier& b) {
    asm volatile("s_waitcnt vmcnt(0)" ::: "memory");
    __syncthreads();
    if (threadIdx.x == 0) {
        unsigned* bar = b.bar;
        __builtin_amdgcn_s_waitcnt(0);
        unsigned nloc = b.st[0], nx = b.st[1];
        if (nloc == 0u) { xcd_barrier_complete(bar, b.x, nloc, nx); b.st[0] = nloc; b.st[1] = nx; }
        const unsigned old = xb_add(&bar[XB_XSUB(b.x)], 1u);
        const unsigned gen = old / nloc;
        if (old + 1u == (gen + 1u) * nloc) {
            __builtin_amdgcn_fence(__ATOMIC_RELEASE, "agent");
            asm volatile("s_waitcnt vmcnt(0)" ::: "memory");
            const unsigned og = xb_add(&bar[XB_TOP], 1u);
            const unsigned tg = og / nx;
            if (og + 1u == (tg + 1u) * nx) xb_add(&bar[XB_TOPGEN], 1u);
            else XB_SPIN(xb_ld(&bar[XB_TOPGEN]) == tg, bar);
            __builtin_amdgcn_fence(__ATOMIC_ACQUIRE, "agent");
            xb_add(&bar[XB_XGEN(b.x)], 1u);
            asm volatile("s_waitcnt vmcnt(0)" ::: "memory");
        } else {
            XB_SPIN(xb_ld(&bar[XB_XGEN(b.x)]) == gen, bar);
            __builtin_amdgcn_fence(__ATOMIC_ACQUIRE, "agent");
            asm volatile("s_waitcnt vmcnt(0)" ::: "memory");
        }
    }
    __syncthreads();
}


struct Ctx {
    LAS unsigned char* lds; int tid, lane, wave, vcu, G;
    float* out; unsigned char* ws;
};
struct Args { const float* in[23]; float* out; unsigned char* ws; int ph_lo, ph_hi; };
#define CIN(k) (A.in[k])

template <int MAP> __device__ __forceinline__ void p0_transpose_item(const float* W, int K, int N, bf16_t* WT, int row_off, LAS float* scr, int item, int lane, const float* gk = nullptr  ) {
    const int nblk = N / 32, kb = item / nblk, nb = item % nblk, k0 = 64 * kb, n0 = 32 * nb;
#pragma unroll 8
    for (int i = 0; i < 32; ++i) { const int kk = 2 * i + (lane >> 5); scr[kk * 33 + (lane & 31)] = W[(size_t)(k0 + kk) * N + n0 + (lane & 31)] * (gk ? gk[k0 + kk] : 1.0f); }
    LDS_WAIT(); asm volatile("" ::: "memory");
    int r0 = row_off + n0;
    if (MAP == 1) { const int half = n0 / DFF, f = n0 % DFF; r0 = (f / 128) * 256 + half * 128 + (f % 128); }
    const int c = lane & 7;
#pragma unroll
    for (int j = 0; j < 4; ++j) { const int n = (lane >> 3) + 8 * j; const LAS float* s = scr + (8 * c) * 33 + n;
        u32x4 o; o.x = pk2(s[0 * 33], s[1 * 33]); o.y = pk2(s[2 * 33], s[3 * 33]); o.z = pk2(s[4 * 33], s[5 * 33]); o.w = pk2(s[6 * 33], s[7 * 33]);
        *(u32x4*)(WT + (size_t)(r0 + n) * K + k0 + 8 * c) = o; }
    LDS_WAIT(); asm volatile("" ::: "memory");
}

__device__ __forceinline__ void ld8_bf16(f32x4& a, f32x4& b, const bf16_t* p) { const u32x4 w = *(const u32x4*)p; a = (f32x4){bflo(w.x), bfhi(w.x), bflo(w.y), bfhi(w.y)}; b = (f32x4){bflo(w.z), bfhi(w.z), bflo(w.w), bfhi(w.w)}; }
template <bool XIN_F32, bool HAS_MM> __device__ __forceinline__ void row_load(f32x4 (&v)[4], f32x4 (&m)[4], const void* xin, const bf16_t* mm, const bf16_t* pb, int ns, int lane) {
#pragma unroll
    for (int j = 0; j < 2; ++j) { const int e = 8 * lane + 512 * j;
        if (XIN_F32) { v[2 * j] = *(const f32x4*)((const float*)xin + e); v[2 * j + 1] = *(const f32x4*)((const float*)xin + e + 4); }
        else ld8_bf16(v[2 * j], v[2 * j + 1], (const bf16_t*)xin + e); }
    if (HAS_MM) {
#pragma unroll
        for (int j = 0; j < 2; ++j) { const int e = 8 * lane + 512 * j;
            if (pb) { ld8_bf16(m[2 * j], m[2 * j + 1], pb + e);
                for (int k = 1; k < ns; ++k) { f32x4 a, b; ld8_bf16(a, b, pb + (size_t)k * (MTS * D) + e); m[2 * j] = m[2 * j] + a; m[2 * j + 1] = m[2 * j + 1] + b; } }
            else ld8_bf16(m[2 * j], m[2 * j + 1], mm + e); }
    }
}
template <bool HAS_MM, bool OUT_F32, int WANT_RSTD  > __device__ __forceinline__ void row_finish(f32x4 (&v)[4], const f32x4 (&m)[4], const f32x4 (&g)[4], void* xout, float* rstd_out, int lane) {
    if (HAS_MM) {
        float s = 0.f;
#pragma unroll
        for (int j = 0; j < 4; ++j) s += (m[j].x * m[j].x + m[j].y * m[j].y) + (m[j].z * m[j].z + m[j].w * m[j].w);
        const float rs = __builtin_amdgcn_rsqf(wave_sum(s) * (1.f / D) + EPS);
#pragma unroll
        for (int j = 0; j < 4; ++j) v[j] = v[j] + m[j] * rs * g[j];
    }
#pragma unroll
    for (int j = 0; j < 2; ++j) { const int e = 8 * lane + 512 * j;
        if (OUT_F32) { *(f32x4*)((float*)xout + e) = v[2 * j]; *(f32x4*)((float*)xout + e + 4) = v[2 * j + 1]; }
        else { u32x4 w; w.x = pg8::cvt_pk_bf16(v[2 * j].x, v[2 * j].y); w.y = pg8::cvt_pk_bf16(v[2 * j].z, v[2 * j].w); w.z = pg8::cvt_pk_bf16(v[2 * j + 1].x, v[2 * j + 1].y); w.w = pg8::cvt_pk_bf16(v[2 * j + 1].z, v[2 * j + 1].w);
            *(u32x4*)((bf16_t*)xout + e) = w; } }
    if (WANT_RSTD) {
        float s = 0.f;
#pragma unroll
        for (int j = 0; j < 4; ++j) s += (v[j].x * v[j].x + v[j].y * v[j].y) + (v[j].z * v[j].z + v[j].w * v[j].w);
        const float tot = wave_sum(s);
        if (WANT_RSTD == 2) { if (lane < 4) rstd_out[lane] = lane == 0 ? tot : 0.f; }
        else if (lane == 0) rstd_out[0] = __builtin_amdgcn_rsqf(tot * (1.f / D) + EPS);
    }
}
template <bool XIN_F32, bool HAS_MM, bool OUT_F32, bool WANT_RSTD> __device__ __forceinline__ void row_op(const void* xin, const bf16_t* mm, const bf16_t* pb, int ns, const float* g1, void* xout, float* rstd_out, int lane) {
    f32x4 v[4], m[4], g[4];
#pragma unroll
    for (int j = 0; j < 4; ++j) g[j] = HAS_MM ? *(const f32x4*)(g1 + 8 * lane + 512 * (j >> 1) + 4 * (j & 1)) : (f32x4){0.f, 0.f, 0.f, 0.f};
    row_load<XIN_F32, HAS_MM>(v, m, xin, mm, pb, ns, lane);
    row_finish<HAS_MM, OUT_F32, WANT_RSTD>(v, m, g, xout, rstd_out, lane);
}
template <int XSRC, bool OUT_F32, bool WANT_RSTD> __device__ __forceinline__ void rowop_phase(const float* xp, const float* xs, bf16_t* XB, const bf16_t* MMb, const bf16_t* PB, int ns, const float* g1, float* outf, float* RSTD, int gw, int NGW, int lane) {
    f32x4 g[4];
#pragma unroll
    for (int j = 0; j < 4; ++j) g[j] = *(const f32x4*)(g1 + 8 * lane + 512 * (j >> 1) + 4 * (j & 1));
    for (int m0 = gw; m0 < MT; m0 += 2 * NGW) {
        const int m1 = m0 + NGW; const bool has1 = m1 < MT;
        f32x4 v0[4], q0[4], v1[4], q1[4];
        const void* x0 = XSRC == 0 ? (const void*)(m0 < MTP ? xp + (size_t)m0 * D : xs + (size_t)(m0 - MTP) * D) : (const void*)(XB + (size_t)m0 * D);
        row_load<XSRC == 0, true>(v0, q0, x0, MMb + (size_t)m0 * D, m0 >= MTP ? PB + (size_t)(m0 - MTP) * D : nullptr, ns, lane);
        if (has1) { const void* x1 = XSRC == 0 ? (const void*)(m1 < MTP ? xp + (size_t)m1 * D : xs + (size_t)(m1 - MTP) * D) : (const void*)(XB + (size_t)m1 * D);
            row_load<XSRC == 0, true>(v1, q1, x1, MMb + (size_t)m1 * D, m1 >= MTP ? PB + (size_t)(m1 - MTP) * D : nullptr, ns, lane); }
        row_finish<true, OUT_F32, WANT_RSTD>(v0, q0, g, OUT_F32 ? (void*)(outf + (size_t)m0 * D) : (void*)(XB + (size_t)m0 * D), RSTD + m0, lane);
        if (has1) row_finish<true, OUT_F32, WANT_RSTD>(v1, q1, g, OUT_F32 ? (void*)(outf + (size_t)m1 * D) : (void*)(XB + (size_t)m1 * D), RSTD + m1, lane);
    }
}

template <int XSRC, bool OUT_F32, bool WANT_RSTD> __device__ __forceinline__ void sample_rowop_after_gemm(const Ctx& C, const pg8::SchedTail& S, unsigned* cnt, const float* xs, bf16_t* XB, const bf16_t* PB, const float* g1, float* outf, float* RSTD) {
    pg8::Unit u; bool any = false;
    for (int i = 0; S.next(i, u); ++i) any |= (u.kind == 1);
    if (!any) return;
    f32x4 g[4];
#pragma unroll
    for (int j = 0; j < 4; ++j) g[j] = *(const f32x4*)(g1 + 8 * C.lane + 512 * (j >> 1) + 4 * (j & 1));
    for (int i = 0; S.next(i, u); ++i) {
        if (u.kind != 1) continue;
        const unsigned target = 4u * (unsigned)S.NS; const int nrows = 256 / (4 * S.NS), r0 = u.pm * 256 + (u.pn * S.NS + u.ks) * nrows;
        if (C.tid == 0) { unsigned sp = 0;
            while (__hip_atomic_load(cnt + 64 * (u.pm - 64), __ATOMIC_RELAXED, __HIP_MEMORY_SCOPE_AGENT) < target) { __builtin_amdgcn_s_sleep(2); if (++sp > (1u << 22)) break; }
            __builtin_amdgcn_fence(__ATOMIC_ACQUIRE, "agent"); asm volatile("s_waitcnt vmcnt(0)" ::: "memory"); }
        __syncthreads();
        for (int k = C.wave; k < nrows; k += 8) {
            const int m0 = r0 + k; f32x4 v0[4], q0[4];
            const void* x0 = XSRC == 0 ? (const void*)(xs + (size_t)(m0 - MTP) * D) : (const void*)(XB + (size_t)m0 * D);
            row_load<XSRC == 0, true>(v0, q0, x0, nullptr, PB + (size_t)(m0 - MTP) * D, S.NS, C.lane);
            row_finish<true, OUT_F32, WANT_RSTD ? 2 : 0>(v0, q0, g, OUT_F32 ? (void*)(outf + (size_t)m0 * D) : (void*)(XB + (size_t)m0 * D), RSTD + (size_t)m0 * 4, C.lane);
        }
    }
}

template <int STAGE> __device__ __forceinline__ void p0_stage(const Ctx& C, const Args& A, int widx, int nw) {
    LAS float* scr = (LAS float*)(C.lds + C.wave * 16384);
    const int gw = widx * NWAVES + C.wave, NGW = nw * NWAVES;
    unsigned char* ws = C.ws; unsigned char* ob = (unsigned char*)C.out;
    constexpr int I_G1 = 16 * 192, I_G3 = 48 * 32, I_F1 = 16 * 176, I_F2 = 44 * 32, I_R1 = 16 * 64, I_R2 = 16 * 32, I_AX = 8;
    if constexpr (STAGE == 0) {
        for (int it = gw; it < I_G1; it += NGW) p0_transpose_item<0>(A.in[5], 1024, 6144, (bf16_t*)(ob + DO_WG1), 0, scr, it, C.lane, A.in[4] + 0 * D);
        for (int m = gw; m < MT; m += NGW) {
            const float* xr = m < MTP ? A.in[0] + (size_t)m * D : A.in[1] + (size_t)(m - MTP) * D;
            row_op<true, false, false, true>(xr, nullptr, nullptr, 0, nullptr, (bf16_t*)(ob + DO_HN) + (size_t)m * D, (float*)(ws + WS_RSTD) + m, C.lane);
        }
    }
    if constexpr (STAGE == 1) {
        constexpr int NITEMS = I_G3 + I_F1 + I_F2 + I_R1 + 16 * I_AX;
        for (int it = gw; it < NITEMS; it += NGW) {
            int r = it;
            if (r < I_G3) { p0_transpose_item<0>(A.in[11], 3072, 1024, (bf16_t*)(ws + WS_WG3), 0, scr, r, C.lane); continue; } r -= I_G3;
            if (r < I_F1) { p0_transpose_item<1>(A.in[21], 1024, 5632, (bf16_t*)(ws + WS_WF1), 0, scr, r, C.lane, A.in[4] + 2 * D); continue; } r -= I_F1;
            if (r < I_F2) { p0_transpose_item<0>(A.in[22], 2816, 1024, (bf16_t*)(ws + WS_WF2), 0, scr, r, C.lane); continue; } r -= I_F2;
            if (r < I_R1) { p0_transpose_item<0>(A.in[12], 1024, 2048, (bf16_t*)(ws + WS_WR1), 0, scr, r, C.lane, A.in[4] + 4 * D); continue; } r -= I_R1;
            { const int hg = r / I_AX, h = hg >> 1, gate = hg & 1;
              p0_transpose_item<0>((gate ? A.in[17] : A.in[15]) + (size_t)h * 16384, 128, 128, (bf16_t*)(ws + WS_WAX) + (size_t)h * 256 * 128, gate * 128, scr, r % I_AX, C.lane); }
        }
        const int gt = widx * NTHR + C.tid, NGT = nw * NTHR;
        for (int i = gt; i < 8 * 128 * 128; i += NGT) { const int t = (i >> 7) & 127, sx = i & 127; ((bf16_t*)(ws + WS_WSB))[i] = (bf16_t)f2bf(sx <= t ? A.in[9][i] : 0.f); }
        for (int i = gt; i < 1024; i += NGT) { const float l = A.in[19][i]; ((float*)(ws + WS_SP))[i] = (l < 0.f ? -l : 0.f) + log1pf(expf(-fabsf(l))); }
    }
    if constexpr (STAGE == 2) {
        constexpr int NITEMS = I_R2 + I_F1 + I_F2;
        for (int it = gw; it < NITEMS; it += NGW) {
            int r = it;
            if (r < I_R2) { p0_transpose_item<0>(A.in[20], 1024, 1024, (bf16_t*)(ws + WS_WR2), 0, scr, r, C.lane); continue; } r -= I_R2;
            if (r < I_F1) { p0_transpose_item<1>(A.in[21] + (size_t)1024 * 5632, 1024, 5632, (bf16_t*)(ws + WS_WF1B), 0, scr, r, C.lane, A.in[4] + 6 * D); continue; } r -= I_F1;
            p0_transpose_item<0>(A.in[22] + (size_t)2816 * 1024, 2816, 1024, (bf16_t*)(ws + WS_WF2B), 0, scr, r, C.lane);
        }
    }
}
template <int STAGE> __device__ __forceinline__ void p0_in_tail(const Ctx& C, const Args& A, int nunits, int bx) {
    const int nbusy = nunits % C.G;
    if (nbusy == 0) p0_stage<STAGE>(C, A, C.vcu, C.G);
    else if (bx >= nbusy) p0_stage<STAGE>(C, A, bx - nbusy, C.G - nbusy);
}

__device__ __forceinline__ void spatial_stats(const Ctx& C, int tok0, LAS float* RS, LAS float* MUR) {
    if (C.tid < 128) { const f32x2* ST = (const f32x2*)(C.ws + WS_ST); float s = 0.f, q = 0.f;
#pragma unroll 8
        for (int p = 0; p < 24; ++p) { const f32x2 v = ST[(size_t)p * MT + tok0 + C.tid]; s += v.x; q += v.y; }
        const float mean = s * (1.f / DG), var = q * (1.f / DG) - mean * mean, rstd = __builtin_amdgcn_rsqf(var + EPS);
        RS[C.tid] = rstd; MUR[C.tid] = mean * rstd; }
}
template <bool DRY> __device__ __forceinline__ void spatial_phase(const Ctx& C, const Args& A) {
    LAS unsigned char* lds = C.lds;
    LAS float* RS = (LAS float*)(lds + 34816); LAS float* MUR = (LAS float*)(lds + 36864);
    const int fr = C.lane & 15, fq = C.lane >> 4;
    bf16_t* U = (bf16_t*)(C.ws + WS_U); const bf16_t* VT = (const bf16_t*)(C.ws + WS_V); const bf16_t* WSB = (const bf16_t*)(C.ws + WS_WSB);
    const float* ln_g = A.in[7]; const float* ln_b = A.in[8]; const float* b_s = A.in[10]; const float* w_s = A.in[9];
    const f32x2* ST = (const f32x2*)(C.ws + WS_ST);
    for (int base = C.vcu; base < 1024; base += 4 * C.G) {
        const int g = base & 7;
        __syncthreads();
        { const int i = C.tid >> 7, t = C.tid & 127, id = base + C.G * i;
          if (id < 1024) { const int tok = (id >> 3) * 128 + t; float sm = 0.f, q = 0.f;
#pragma unroll 8
            for (int p = 0; p < 24; ++p) { const f32x2 v = ST[(size_t)p * MT + tok]; sm += v.x; q += v.y; }
            const float mean = sm * (1.f / DG), var = q * (1.f / DG) - mean * mean, rstd = __builtin_amdgcn_rsqf(var + EPS);
            RS[C.tid] = rstd; MUR[C.tid] = mean * rstd; } }
#pragma unroll
        for (int i = 0; i < 4; ++i) { const int p = C.tid + 512 * i, row = p >> 4, c16 = p & 15;
            const u32x4 w = *(const u32x4*)(WSB + (size_t)g * 16384 + row * 128 + c16 * 8); *(LAS u32x4*)(lds + row * 272 + c16 * 16) = w; }
        __syncthreads();
        float bsv[8];
#pragma unroll
        for (int m = 0; m < 8; ++m) bsv[m] = b_s[g * 128 + 16 * m + fr];
        u32x4 rB[3][4]; u32x2 rU[3][8]; float rG[3], rBn[3];
#define SP_ISSUE(s_) do { const int i_ = (s_) / 3, j_ = (s_) % 3, sl_ = (s_) % 3, id_ = base + C.G * i_; if (id_ < 1024) { const int tok0_ = (id_ >> 3) * 128, chb_ = g * 384 + 48 * C.wave + 16 * j_; \
            rG[sl_] = ln_g[chb_ + fr]; rBn[sl_] = ln_b[chb_ + fr]; \
            _Pragma("unroll") for (int kk = 0; kk < 4; ++kk) rB[sl_][kk] = *(const u32x4*)(VT + (size_t)(chb_ + fr) * MT + tok0_ + 32 * kk + 8 * fq); \
            _Pragma("unroll") for (int m = 0; m < 8; ++m) rU[sl_][m] = *(const u32x2*)(U + (size_t)(tok0_ + 16 * m + fr) * DG + chb_ + 4 * fq); } } while (0)
        SP_ISSUE(0); SP_ISSUE(1);
#pragma unroll
        for (int s = 0; s < 12; ++s) {
            if (s + 2 < 12) SP_ISSUE(s + 2);
            const int i = s / 3, j = s % 3, sl = s % 3, id = base + C.G * i;
            if (id < 1024) {
                const int tok0 = (id >> 3) * 128, chb = g * 384 + 48 * C.wave + 16 * j;
                const float Gc = rG[sl], Bc = rBn[sl];
                bf16x8 bfrag[4];
#pragma unroll
                for (int kk = 0; kk < 4; ++kk) {
                    const u32x4 raw = rB[sl][kk];
                    const LAS float* rp = RS + i * 128 + 32 * kk + 8 * fq; const LAS float* mp = MUR + i * 128 + 32 * kk + 8 * fq;
                    const f32x4 r0 = *(const LAS f32x4*)rp, r1 = *(const LAS f32x4*)(rp + 4), m0 = *(const LAS f32x4*)mp, m1 = *(const LAS f32x4*)(mp + 4);
                    const f32x4 vlo = (f32x4){bflo(raw.x), bfhi(raw.x), bflo(raw.y), bfhi(raw.y)}, vhi = (f32x4){bflo(raw.z), bfhi(raw.z), bflo(raw.w), bfhi(raw.w)};
                    const f32x4 o0 = vlo * (r0 * Gc) + (Bc - m0 * Gc), o1 = vhi * (r1 * Gc) + (Bc - m1 * Gc);
                    u32x4 w; w.x = pg8::cvt_pk_bf16(o0.x, o0.y); w.y = pg8::cvt_pk_bf16(o0.z, o0.w); w.z = pg8::cvt_pk_bf16(o1.x, o1.y); w.w = pg8::cvt_pk_bf16(o1.z, o1.w);
                    bfrag[kk] = __builtin_bit_cast(bf16x8, w);
                }
#pragma unroll
                for (int m = 0; m < 8; ++m) { f32x4 acc = (f32x4){0.f, 0.f, 0.f, 0.f};
#pragma unroll
                    for (int kk = 0; kk < 4; ++kk) if (kk <= (m >> 1)) {
                        const bf16x8 af = *(const LAS bf16x8*)(lds + (16 * m + fr) * 272 + (32 * kk + 8 * fq) * 2);
                        acc = __builtin_amdgcn_mfma_f32_16x16x32_bf16(bfrag[kk], af, acc, 0, 0, 0); }
                    const float bs = bsv[m]; const u32x2 uw = rU[sl][m];
                    u32x2 o; o.x = pg8::cvt_pk_bf16(bflo(uw.x) * (acc[0] + bs), bfhi(uw.x) * (acc[1] + bs)); o.y = pg8::cvt_pk_bf16(bflo(uw.y) * (acc[2] + bs), bfhi(uw.y) * (acc[3] + bs));
                    *(u32x2*)(U + (size_t)(tok0 + 16 * m + fr) * DG + chb + 4 * fq) = o; }
            }
        }
#undef SP_ISSUE
    }
    for (int r = C.vcu; r < 256; r += C.G) {
        const int sc = r >> 5, g = (r >> 2) & 7, quarter = r & 3, tok0 = MTP + sc * 128;
        __syncthreads();
        if (C.tid < 128) { float sm = 0.f, q = 0.f;
#pragma unroll 8
            for (int p = 0; p < 24; ++p) { const f32x2 v = ST[(size_t)p * MT + tok0 + C.tid]; sm += v.x; q += v.y; }
            const float mean = sm * (1.f / DG), var = q * (1.f / DG) - mean * mean, rstd = __builtin_amdgcn_rsqf(var + EPS);
            RS[C.tid] = rstd; MUR[C.tid] = mean * rstd; }
        __syncthreads();
        float* OV = C.out + O_SV;
#pragma unroll
        for (int p4 = 0; p4 < 3; ++p4) { const int p = C.tid + NTHR * p4;
            const int dbl = p / 96, cl = p - dbl * 96, ch = g * 384 + quarter * 96 + cl, db = sc * 16 + dbl;
            const float Gc = ln_g[ch], Bc = ln_b[ch];
            const u32x4 raw = *(const u32x4*)(VT + (size_t)ch * MT + MTP + db * 8);
            float vn[8]; const float vv[8] = {bflo(raw.x), bfhi(raw.x), bflo(raw.y), bfhi(raw.y), bflo(raw.z), bfhi(raw.z), bflo(raw.w), bfhi(raw.w)};
#pragma unroll
            for (int sx = 0; sx < 8; ++sx) { vn[sx] = vv[sx] * (RS[dbl * 8 + sx] * Gc) + (Bc - MUR[dbl * 8 + sx] * Gc); OV[(size_t)(db * 8 + sx) * DG + ch] = vn[sx]; }
#pragma unroll
            for (int t = 0; t < 8; ++t) { float mx = b_s[g * 128 + t];
#pragma unroll
                for (int sx = 0; sx <= t; ++sx) mx += w_s[g * 16384 + t * 128 + sx] * vn[sx];
                bf16_t* up = U + (size_t)(MTP + db * 8 + t) * DG + ch; *up = (bf16_t)f2bf(bflo((unsigned)*up) * mx); }
        }
    }
    __syncthreads();
}

constexpr int RG_TILE = 64, RG_NT = MT / RG_TILE  , RG_NTP = MTP / RG_TILE  , RG_PITCH = 132;
__device__ __forceinline__ float one_minus_exp(float x, float ex  ) {
    float p = x * (1.f / 5040.f) + (1.f / 720.f); p = p * x + (1.f / 120.f); p = p * x + (1.f / 24.f); p = p * x + (1.f / 6.f); p = p * x + 0.5f; p = p * x + 1.0f; p = -(p * x);
    const float e = 1.0f - ex;
    return x > -0.3f ? p : e;
}
__device__ __forceinline__ void rg_phase1(const Ctx& C, const Args& A) {
    LAS unsigned char* lds = C.lds;
    LAS float* XC = (LAS float*)(lds + 69632); LAS float* BB = XC; LAS float* AA = (LAS float*)(lds + 103424); LAS f32x2* SUM = (LAS f32x2*)(lds + 137216);
    const int fr = C.lane & 15, fq = C.lane >> 4, h = C.vcu & 7;
    const bf16_t* XBR = (const bf16_t*)(C.ws + WS_U) + (size_t)MT * D; const bf16_t* WAX = (const bf16_t*)(C.ws + WS_WAX); const float* SP = (const float*)(C.ws + WS_SP);
    bf16_t* GATE = (bf16_t*)(C.ws + WS_U); f32x2* TS = (f32x2*)(C.ws + WS_TS); unsigned* FLG = (unsigned*)(C.ws + WS_FLG); LAS float* CARRY = (LAS float*)(lds + 137216 + 4096);
    const float* conv_w = A.in[13]; const float* conv_b = A.in[14]; const float* b_a = A.in[16]; const float* b_x = A.in[18]; const float* st_conv = A.in[2]; const float* st_h = A.in[3];
#pragma unroll
    for (int i = 0; i < 8; ++i) { const int p = C.tid + 512 * i, row = p >> 4, c16 = p & 15; *(LAS u32x4*)(lds + row * 272 + c16 * 16) = *(const u32x4*)(WAX + ((size_t)h * 256 + row) * 128 + c16 * 8); }
    const int cg8 = C.tid & 15, tr = C.tid >> 4, c8 = h * 128 + cg8 * 8;
    f32x4 w[4][2], bb[2];
#pragma unroll
    for (int k = 0; k < 4; ++k) { w[k][0] = *(const f32x4*)(conv_w + k * 1024 + c8); w[k][1] = *(const f32x4*)(conv_w + k * 1024 + c8 + 4); }
    bb[0] = *(const f32x4*)(conv_b + c8); bb[1] = *(const f32x4*)(conv_b + c8 + 4);
    const int mb = C.wave & 3, nh = C.wave >> 2;
    LAS float* HC = (LAS float*)(lds + 141824);
    if (C.tid < 128) { HC[C.tid] = b_a[h * 128 + C.tid]; HC[128 + C.tid] = b_x[h * 128 + C.tid]; HC[256 + C.tid] = SP[h * 128 + C.tid]; }
    u32x4 pre[2][4];
#define RG_LOADROWS(tile_) do { const int tok0_ = (tile_) * RG_TILE; const bool smp_ = (tile_) >= RG_NTP; \
        _Pragma("unroll") for (int i = 0; i < 2; ++i) { const int tok_ = tok0_ + tr + 32 * i, tl_ = smp_ ? ((tok_ - MTP) & 7) : (tok_ & (SEQ - 1)); \
            _Pragma("unroll") for (int k = 0; k < 4; ++k) { pre[i][k] = (u32x4){0u, 0u, 0u, 0u}; if (tl_ + k - 3 >= 0) pre[i][k] = *(const u32x4*)(XBR + (size_t)(tok_ + k - 3) * D + c8); } } } while (0)
    if (C.vcu < RG_NT * 8) RG_LOADROWS(C.vcu >> 3);
    __syncthreads();
    for (int id = C.vcu; id < RG_NT * 8; id += C.G) {
        const int tile = id >> 3, tok0 = tile * RG_TILE; const bool sample = tile >= RG_NTP;
        {
#pragma unroll
            for (int i = 0; i < 2; ++i) { const int t = tr + 32 * i, tok = tok0 + t;
                const int L = sample ? 8 : SEQ, tl = sample ? ((tok - MTP) & 7) : (tok & (SEQ - 1)), sq = sample ? ((tok - MTP) >> 3) : (tok >> 11);
                f32x4 x0 = bb[0], x1 = bb[1];
#pragma unroll
                for (int k = 0; k < 4; ++k) { const u32x4 raw = pre[i][k];
                    f32x4 r0 = (f32x4){bflo(raw.x), bfhi(raw.x), bflo(raw.y), bfhi(raw.y)}, r1 = (f32x4){bflo(raw.z), bfhi(raw.z), bflo(raw.w), bfhi(raw.w)};
                    if (sample && tl + k - 3 < 0) { const float* hp = st_conv + (size_t)(sq * 3 + (tl + k)) * D + c8; r0 = *(const f32x4*)hp; r1 = *(const f32x4*)(hp + 4); }
                    x0 = x0 + w[k][0] * r0; x1 = x1 + w[k][1] * r1;
                    if (k == 3 && tl >= L - 3) { float* op = C.out + (sample ? O_SCONV : O_PCONV) + (size_t)(sq * 3 + (tl - (L - 3))) * D + c8; *(f32x4*)op = r0; *(f32x4*)(op + 4) = r1; } }
                *(LAS f32x4*)(XC + t * RG_PITCH + cg8 * 8) = x0; *(LAS f32x4*)(XC + t * RG_PITCH + cg8 * 8 + 4) = x1; }
        }
        __syncthreads();
        bf16x8 af[4]; f32x4 xc4[4];
        {
#pragma unroll
            for (int kk = 0; kk < 4; ++kk) { const LAS float* xp = XC + (16 * mb + fr) * RG_PITCH + 32 * kk + 8 * fq; const f32x4 a0 = *(const LAS f32x4*)xp, a1 = *(const LAS f32x4*)(xp + 4);
                u32x4 wv; wv.x = pg8::cvt_pk_bf16(a0.x, a0.y); wv.y = pg8::cvt_pk_bf16(a0.z, a0.w); wv.z = pg8::cvt_pk_bf16(a1.x, a1.y); wv.w = pg8::cvt_pk_bf16(a1.z, a1.w); af[kk] = __builtin_bit_cast(bf16x8, wv); }
#pragma unroll
            for (int nb = 0; nb < 4; ++nb) xc4[nb] = *(const LAS f32x4*)(XC + (16 * mb + fr) * RG_PITCH + 64 * nh + 16 * nb + 4 * fq);
        }
        __syncthreads();
        if (id + C.G < RG_NT * 8) RG_LOADROWS((id + C.G) >> 3);
        u32x4 gpre[2];
#pragma unroll
        for (int i = 0; i < 2; ++i) { const int p = C.tid + 512 * i; gpre[i] = *(const u32x4*)(GATE + (size_t)(tok0 + (p >> 4)) * D + h * 128 + (p & 15) * 8); }
        {
#pragma unroll
            for (int nb = 0; nb < 4; ++nb) {
                f32x4 ra = (f32x4){0.f, 0.f, 0.f, 0.f}, ia = ra;
                const LAS unsigned char* wp = lds + (64 * nh + 16 * nb + fr) * 272 + 16 * fq;
#pragma unroll
                for (int kk = 0; kk < 4; ++kk) { const bf16x8 ba = *(const LAS bf16x8*)(wp + 64 * kk), bx = *(const LAS bf16x8*)(wp + 128 * 272 + 64 * kk);
                    ra = __builtin_amdgcn_mfma_f32_16x16x32_bf16(ba, af[kk], ra, 0, 0, 0); ia = __builtin_amdgcn_mfma_f32_16x16x32_bf16(bx, af[kk], ia, 0, 0, 0); }
                const int t = 16 * mb + fr, cl = 64 * nh + 16 * nb + 4 * fq;
                f32x4 av, bv; const f32x4 bav = *(const LAS f32x4*)(HC + cl), bxv = *(const LAS f32x4*)(HC + 128 + cl), spv = *(const LAS f32x4*)(HC + 256 + cl);
#pragma unroll
                for (int j = 0; j < 4; j += 2) {
                    const f32x2 zr = ((f32x2){ra[j], ra[j + 1]} + (f32x2){bav[j], bav[j + 1]}) * -1.4426950409f, zi = ((f32x2){ia[j], ia[j + 1]} + (f32x2){bxv[j], bxv[j + 1]}) * -1.4426950409f;
                    f32x2 er, ei; er.x = __builtin_amdgcn_exp2f(zr.x); er.y = __builtin_amdgcn_exp2f(zr.y); ei.x = __builtin_amdgcn_exp2f(zi.x); ei.y = __builtin_amdgcn_exp2f(zi.y);
                    const f32x2 dr = er + 1.0f, di = ei + 1.0f; f32x2 r, ii; r.x = __builtin_amdgcn_rcpf(dr.x); r.y = __builtin_amdgcn_rcpf(dr.y); ii.x = __builtin_amdgcn_rcpf(di.x); ii.y = __builtin_amdgcn_rcpf(di.y);
                    const f32x2 la = r * (f32x2){spv[j], spv[j + 1]} * -8.0f, le = la * 1.4426950409f; f32x2 a; a.x = __builtin_amdgcn_exp2f(le.x); a.y = __builtin_amdgcn_exp2f(le.y);
                    const f32x2 x2 = la * 2.0f;
                    f32x2 p = x2 * (1.f / 5040.f) + (1.f / 720.f); p = p * x2 + (1.f / 120.f); p = p * x2 + (1.f / 24.f); p = p * x2 + (1.f / 6.f); p = p * x2 + 0.5f; p = p * x2 + 1.0f; p = -(p * x2);
                    const f32x2 e = 1.0f - a * a; f32x2 om; om.x = x2.x > -0.3f ? p.x : e.x; om.y = x2.y > -0.3f ? p.y : e.y;
                    f32x2 sq; sq.x = __builtin_amdgcn_sqrtf(om.x); sq.y = __builtin_amdgcn_sqrtf(om.y);
                    const f32x2 b2 = sq * (ii * (f32x2){xc4[nb][j], xc4[nb][j + 1]});
                    av[j] = a.x; av[j + 1] = a.y; bv[j] = b2.x; bv[j + 1] = b2.y; }
                *(LAS f32x4*)(AA + t * RG_PITCH + cl) = av; *(LAS f32x4*)(BB + t * RG_PITCH + cl) = bv;
            }
        }
        __syncthreads();
        {
            const int chl = C.tid & 127, q = C.tid >> 7, ch = h * 128 + chl;
            if (!sample) {
                float Ap = 1.f, Bp = 0.f;
#pragma unroll 4
                for (int t = 16 * q; t < 16 * q + 16; ++t) { const float a = AA[t * RG_PITCH + chl], b = BB[t * RG_PITCH + chl]; Bp = a * Bp + b; Ap *= a; }
                SUM[q * 128 + chl] = (f32x2){Ap, Bp};
                __syncthreads();
                const int first = tile & ~31, nprev = tile & 31;
                if (C.tid < 128) { float At = 1.f, Bt = 0.f;
#pragma unroll
                    for (int qq = 0; qq < 4; ++qq) { const f32x2 sm = SUM[qq * 128 + chl]; Bt = sm.x * Bt + sm.y; At *= sm.x; }
                    __hip_atomic_store((unsigned long long*)(TS + (size_t)tile * D + ch), ((unsigned long long)__float_as_uint(Bt) << 32) | __float_as_uint(At), __ATOMIC_RELAXED, __HIP_MEMORY_SCOPE_AGENT); }
                asm volatile("s_waitcnt vmcnt(0)" ::: "memory");
                __syncthreads();
                if (C.tid == 0) __hip_atomic_store(FLG + (size_t)(tile * 8 + h) * 16, 1u, __ATOMIC_RELAXED, __HIP_MEMORY_SCOPE_AGENT);
                if (C.wave == 0) { unsigned sp = 0;
                    for (;;) { const unsigned f = C.lane < nprev ? __hip_atomic_load(FLG + (size_t)((first + C.lane) * 8 + h) * 16, __ATOMIC_RELAXED, __HIP_MEMORY_SCOPE_AGENT) : 1u;
                        if (__builtin_amdgcn_ballot_w64(f == 0u) == 0ull) break; __builtin_amdgcn_s_sleep(2); if (++sp > (1u << 22)) break; }
                    __builtin_amdgcn_fence(__ATOMIC_ACQUIRE, "agent"); }
                asm volatile("s_waitcnt vmcnt(0)" ::: "memory");
                __syncthreads();
                if (C.tid < 128) { float carry = 0.f;
#pragma unroll
                    for (int j0 = 0; j0 < 32; j0 += 16) { unsigned long long sv[16];
#pragma unroll
                        for (int j = 0; j < 16; ++j) sv[j] = (j0 + j < nprev) ? __hip_atomic_load((const unsigned long long*)(TS + (size_t)(first + j0 + j) * D + ch), __ATOMIC_RELAXED, __HIP_MEMORY_SCOPE_AGENT) : 0x000000003f800000ull;
#pragma unroll
                        for (int j = 0; j < 16; ++j) carry = __uint_as_float((unsigned)sv[j]) * carry + __uint_as_float((unsigned)(sv[j] >> 32)); }
                    CARRY[chl] = carry; }
                __syncthreads();
                float hv = CARRY[chl];
                for (int qq = 0; qq < q; ++qq) { const f32x2 sm = SUM[qq * 128 + chl]; hv = sm.x * hv + sm.y; }
#pragma unroll 4
                for (int t = 16 * q; t < 16 * q + 16; ++t) { hv = AA[t * RG_PITCH + chl] * hv + BB[t * RG_PITCH + chl]; AA[t * RG_PITCH + chl] = hv; }
                if (q == 3 && nprev == 31) C.out[O_PH + (size_t)(tile >> 5) * D + ch] = hv;
            } else {
#pragma unroll
                for (int s2 = 0; s2 < 2; ++s2) { const int db = ((tok0 - MTP) >> 3) + 2 * q + s2; float hv = st_h[(size_t)db * D + ch];
#pragma unroll
                    for (int t8 = 0; t8 < 8; ++t8) { const int t = 16 * q + 8 * s2 + t8; hv = AA[t * RG_PITCH + chl] * hv + BB[t * RG_PITCH + chl]; AA[t * RG_PITCH + chl] = hv; }
                    C.out[O_SH + (size_t)db * D + ch] = hv; }
            }
        }
        __syncthreads();
#pragma unroll
        for (int i = 0; i < 2; ++i) { const int p = C.tid + 512 * i, t = p >> 4, c8l = (p & 15) * 8;
            const f32x4 h0 = *(const LAS f32x4*)(AA + t * RG_PITCH + c8l), h1 = *(const LAS f32x4*)(AA + t * RG_PITCH + c8l + 4); const u32x4 gt = gpre[i];
            u32x4 o; o.x = pg8::cvt_pk_bf16(h0.x * bflo(gt.x), h0.y * bfhi(gt.x)); o.y = pg8::cvt_pk_bf16(h0.z * bflo(gt.y), h0.w * bfhi(gt.y)); o.z = pg8::cvt_pk_bf16(h1.x * bflo(gt.z), h1.y * bfhi(gt.z)); o.w = pg8::cvt_pk_bf16(h1.z * bflo(gt.w), h1.w * bfhi(gt.w));
            *(u32x4*)(GATE + (size_t)(tok0 + t) * D + h * 128 + c8l) = o; }
        __syncthreads();
    }
#undef RG_LOADROWS
}
template <bool DRY> __device__ __forceinline__ void rg_phase2(const Ctx& C) {
    LAS float* CARRY = (LAS float*)C.lds;
    bf16_t* GATE = (bf16_t*)(C.ws + WS_U); const bf16_t* HL = (const bf16_t*)(C.ws + WS_V); const bf16_t* CA = (const bf16_t*)(C.ws + WS_V + (size_t)MT * D * 4); const f32x2* TS = (const f32x2*)(C.ws + WS_TS);
    for (int id = C.vcu; id < RG_NT * 8; id += C.G) {
        const int tile = id >> 3, h = id & 7, tok0 = tile * RG_TILE; const bool sample = tile >= RG_NTP;
        if (C.tid < 128) { const int ch = h * 128 + C.tid; float carry = 0.f;
            if (!sample) { const int first = tile & ~31, nprev = tile & 31;
                f32x2 sv[31];
#pragma unroll
                for (int j = 0; j < 31; ++j) sv[j] = (j < nprev) ? TS[(size_t)(first + j) * D + ch] : (f32x2){1.f, 0.f};
#pragma unroll
                for (int j = 0; j < 31; ++j) carry = sv[j].x * carry + sv[j].y; }
            CARRY[C.tid] = carry; }
        __syncthreads();
#pragma unroll
        for (int i = 0; i < 2; ++i) { const int p = C.tid + 512 * i, t = p >> 4, cg8 = p & 15, tok = tok0 + t, c8 = h * 128 + cg8 * 8; const size_t off = (size_t)tok * D + c8;
            const u32x4 hlw = *(const u32x4*)(HL + off); const f32x4 h0 = (f32x4){bflo(hlw.x), bfhi(hlw.x), bflo(hlw.y), bfhi(hlw.y)}, h1 = (f32x4){bflo(hlw.z), bfhi(hlw.z), bflo(hlw.w), bfhi(hlw.w)}; const u32x4 ca = *(const u32x4*)(CA + off), gt = *(const u32x4*)(GATE + off);
            const f32x4 c0 = *(const LAS f32x4*)(CARRY + cg8 * 8), c1 = *(const LAS f32x4*)(CARRY + cg8 * 8 + 4);
            f32x4 v0 = h0, v1 = h1;
            if (!sample) { v0 = v0 + (f32x4){bflo(ca.x), bfhi(ca.x), bflo(ca.y), bfhi(ca.y)} * c0; v1 = v1 + (f32x4){bflo(ca.z), bfhi(ca.z), bflo(ca.w), bfhi(ca.w)} * c1; }
            u32x4 o; o.x = pk2(v0.x * bflo(gt.x), v0.y * bfhi(gt.x)); o.y = pk2(v0.z * bflo(gt.y), v0.w * bfhi(gt.y)); o.z = pk2(v1.x * bflo(gt.z), v1.y * bfhi(gt.z)); o.w = pk2(v1.z * bflo(gt.w), v1.w * bfhi(gt.w));
            *(u32x4*)((DRY ? GATE + (size_t)2 * MT * D : GATE) + off) = o;
            if (!sample && (tok & (SEQ - 1)) == SEQ - 1) { float* op = C.out + O_PH + (size_t)(tok >> 11) * D + c8; *(f32x4*)op = v0; *(f32x4*)(op + 4) = v1; } }
        __syncthreads();
    }
}

template <int K, bool DRY = false> __device__ __forceinline__ void run_phase(const Ctx& C, const Args& args) {
    unsigned char* ws = args.ws; unsigned char* ob = (unsigned char*)args.out;
    bf16_t* const Ubuf = (bf16_t*)(ws + WS_U); bf16_t* const Vbuf = (bf16_t*)(ws + WS_V);
    bf16_t* const MMb = Vbuf;
    bf16_t* const HNb = Vbuf + (size_t)MT * D;
    bf16_t* const PB = (bf16_t*)(ws + WS_V + 68 * MiB);
    constexpr int NS_G3 = 8, NS_F2 = 8, NS_G9 = 4;
    const int gw = C.vcu * NWAVES + C.wave, NGW = C.G * NWAVES;
    const float* gains = args.in[4]; float* const RSTD = (float*)(ws + WS_RSTD);
    unsigned* const ECNT = (unsigned*)(ws + WS_CNT); unsigned* const SCNT = ECNT + 4 * 2 * 64 * 64;
    float* const XS1 = (float*)(ws + WS_ST); float* const RS16 = (float*)(ws + WS_ST + 2560 * 1024);
    const int bx = (int)blockIdx.x;

    if constexpr (K == 0) { p0_stage<0>(C, args, C.vcu, C.G); }
    if constexpr (K == 1) {
        const bf16_t* hn0 = (const bf16_t*)(ob + DO_HN); const bf16_t* wg1 = (const bf16_t*)(ob + DO_WG1);
        pg8::Sched S; S.init(hn0, wg1, MT, DG, wg1 + (size_t)DG * D, hn0, DG, MT, D, C.G, bx);
        pg8::EpiG1 E{Ubuf, Vbuf, args.in[6], (f32x2*)(ws + WS_ST), RSTD};
        pg8::gemm_phase(C.lds, D, S, E);
        if (!DRY) p0_in_tail<1>(C, args, 68 * 24, bx);
    }
    if constexpr (K == 2) { spatial_phase<DRY>(C, args); }
    if constexpr (K == 3) {
        pg8::SchedTail S; S.init(Ubuf, ws + WS_WG3, DG, NS_G3, C.G, bx);
        pg8::RmsExchange e1{XS1, ECNT + (0 * 2 + 0) * 4096};
        pg8::EpiTailFused<false> E{PB, SCNT + 0 * 256, e1, (const bf16_t*)(ob + DO_HN), HNb, gains + 1 * D, nullptr, RS16, C.lds + 131072};   pg8::gemm_phase(C.lds, DG, S, E);
        sample_rowop_after_gemm<0, false, true>(C, S, SCNT + 0 * 256, args.in[1], HNb, PB, gains + 1 * D, nullptr, RS16);
    }
    if constexpr (K == 4) {
    }
    if constexpr (K == 5) {
        pg8::Sched S; S.init(HNb, ws + WS_WF1, MT, 2 * DFF, nullptr, nullptr, 0, 0, D, C.G, bx);
        pg8::EpiSwiglu E{Ubuf, RS16}; pg8::gemm_phase(C.lds, D, S, E);
    }
    if constexpr (K == 6) {
        pg8::SchedTail S; S.init(Ubuf, ws + WS_WF2, DFF, NS_F2, C.G, bx);
        pg8::RmsExchange e1{XS1, ECNT + (1 * 2 + 0) * 4096};
        pg8::EpiTailFused<false> E{PB, SCNT + 1 * 256, e1, HNb, HNb, gains + 3 * D, nullptr, RS16, C.lds + 131072}; pg8::gemm_phase(C.lds, DFF, S, E);
        sample_rowop_after_gemm<1, false, true>(C, S, SCNT + 1 * 256, nullptr, HNb, PB, gains + 3 * D, nullptr, RS16);
    }
    if constexpr (K == 7) {
    }
    if constexpr (K == 8) {
        pg8::Sched S; S.init(HNb, ws + WS_WR1, MT, 2 * D, nullptr, nullptr, 0, 0, D, C.G, bx);
        pg8::EpiG6 E{Ubuf, Ubuf + (size_t)MT * D, RS16}; pg8::gemm_phase(C.lds, D, S, E);
        if (!DRY) p0_in_tail<2>(C, args, 68 * 8, bx);
    }
    if constexpr (K == 9) { rg_phase1(C, args); }
    if constexpr (K == 11) {
        pg8::SchedTail S; S.init(Ubuf, ws + WS_WR2, D, NS_G9, C.G, bx);
        pg8::RmsExchange e1{XS1, ECNT + (2 * 2 + 0) * 4096};
        pg8::EpiTailFused<false> E{PB, SCNT + 2 * 256, e1, HNb, HNb, gains + 5 * D, nullptr, RS16, C.lds + 131072}; pg8::gemm_phase(C.lds, D, S, E);
        sample_rowop_after_gemm<1, false, true>(C, S, SCNT + 2 * 256, nullptr, HNb, PB, gains + 5 * D, nullptr, RS16);
    }
    if constexpr (K == 12) {
    }
    if constexpr (K == 13) {
        pg8::Sched S; S.init(HNb, ws + WS_WF1B, MT, 2 * DFF, nullptr, nullptr, 0, 0, D, C.G, bx);
        pg8::EpiSwiglu E{Ubuf, RS16}; pg8::gemm_phase(C.lds, D, S, E);
    }
    if constexpr (K == 14) {
        pg8::SchedTail S; S.init(Ubuf, ws + WS_WF2B, DFF, NS_F2, C.G, bx);
        pg8::RmsExchange e1{XS1, ECNT + (3 * 2 + 0) * 4096};
        pg8::EpiTailFused<true> E{PB, SCNT + 3 * 256, e1, HNb, HNb, gains + 7 * D, args.out, RS16, C.lds + 131072}; pg8::gemm_phase(C.lds, DFF, S, E);
        sample_rowop_after_gemm<1, true, false>(C, S, SCNT + 3 * 256, nullptr, HNb, PB, gains + 7 * D, args.out, RS16);
    }
    if constexpr (K == 15) {
    }
}
constexpr int NPH = 16;
__global__ void __launch_bounds__(NTHR, 2) fwd_kernel(Args args) {
    extern __shared__ __attribute__((aligned(16))) unsigned char lds_raw[];
    Ctx C; C.lds = (LAS unsigned char*)lds_raw; C.tid = threadIdx.x; C.lane = C.tid & 63; C.wave = __builtin_amdgcn_readfirstlane(C.tid >> 6);
    C.G = gridDim.x; { const int bx = blockIdx.x; C.vcu = (C.G % 8 == 0) ? (bx % 8) * (C.G / 8) + bx / 8 : bx; }
    C.out = args.out; C.ws = args.ws;
    for (int u = C.tid; u < 64; u += NTHR) ((LAS unsigned*)(C.lds + LDS_BYTES - 256))[u] = 0u;
    __syncthreads();
    const XcdBarrier bar = xcd_barrier_post((unsigned*)(args.ws + WS_BAR), (volatile LAS unsigned*)(C.lds + LDS_BYTES - 256 + 32));
    const int lo = args.ph_lo, hi = args.ph_hi;
#ifndef REP_MASK
#define REP_MASK 0
#endif
#ifndef XSYNC
#define XSYNC 0
#endif
#define REPS(k) (((REP_MASK >> (k)) & 1) ? 2 : 1)
#ifndef PH_MASK
#define PH_MASK 0xffff
#endif
#define IN(k) (((PH_MASK >> (k)) & 1) && lo <= (k) && (k) < hi)
#if MK_ONE_LAUNCH
#define SEAM(k) do { if ((k) != 3 && (k) != 6 && (k) != 9 && (k) != 11 && (k) != 14 && IN(k) && IN((k) + 1)) { xcd_barrier(bar); } } while (0)
#else
#define SEAM(k) do { } while (0)
#endif
    if (hi == 0x7fffffff) cg::this_grid().sync();
#define PHASE(k) do { if (IN(k)) { if (REPS(k) == 2) run_phase<k, true>(C, args); run_phase<k>(C, args); } SEAM(k); } while (0)
    PHASE(0);
    for (int xs_ = 0; xs_ < XSYNC; ++xs_) cg::this_grid().sync();
    PHASE(1); PHASE(2); PHASE(3); PHASE(4); PHASE(5); PHASE(6); PHASE(7); PHASE(8); PHASE(9); PHASE(10); PHASE(11); PHASE(12); PHASE(13); PHASE(14); PHASE(15);
#undef PHASE
#undef IN
#undef SEAM
}

extern "C" void kernel_launch(void* const* d_in, const int* in_sizes, int n_in, void* d_out, int out_size, void* d_ws, size_t ws_size, hipStream_t stream) {
    static int grid = 0;
    if (grid == 0) {
        int dev = 0, cus = 0, per_cu = 0;
        hipGetDevice(&dev); hipDeviceGetAttribute(&cus, hipDeviceAttributeMultiprocessorCount, dev);
        hipFuncSetAttribute((const void*)fwd_kernel, hipFuncAttributeMaxDynamicSharedMemorySize, LDS_BYTES);
        hipOccupancyMaxActiveBlocksPerMultiprocessor(&per_cu, (const void*)fwd_kernel, NTHR, LDS_BYTES);
        if (per_cu < 1) { fprintf(stderr, "kernel_launch: occupancy query says %d blocks/CU\n", per_cu); per_cu = 1; }
        (void)hipGetLastError();
        grid = cus * per_cu;
        if (n_in != 23 || ws_size < 256 * MiB) fprintf(stderr, "kernel_launch: unexpected n_in %d / ws %zu\n", n_in, ws_size);
    }
    (void)hipMemsetAsync((char*)d_ws + WS_BAR, 0, CTL_ZERO_BYTES, stream);
    Args a{};
    for (int i = 0; i < 23; ++i) a.in[i] = (const float*)d_in[i];
    a.out = (float*)d_out; a.ws = (unsigned char*)d_ws;
#if MK_ONE_LAUNCH
    a.ph_lo = 0; a.ph_hi = NPH;
    void* kargs[] = {&a};
    hipError_t e = hipLaunchCooperativeKernel((const void*)fwd_kernel, dim3(grid), dim3(NTHR), kargs, LDS_BYTES, stream);
    if (e != hipSuccess) fprintf(stderr, "cooperative launch failed: %s (grid %d)\n", hipGetErrorString(e), grid);
#else
    for (int p = 0; p < NPH; ++p) { a.ph_lo = p; a.ph_hi = p + 1; hipLaunchKernelGGL(fwd_kernel, dim3(grid), dim3(NTHR), LDS_BYTES, stream, a); }
#endif
}
```

```cpp
#include <hip/hip_runtime.h>
#include <hip/hip_cooperative_groups.h>
#include <cstdio>
#include <cstdint>
#include <cmath>
namespace cg = cooperative_groups;

#ifndef MK_ONE_LAUNCH
#define MK_ONE_LAUNCH 1
#endif

#define LAS __attribute__((address_space(3)))
typedef unsigned short bf16_t;
typedef short bf16x8 __attribute__((ext_vector_type(8)));
typedef float f32x4 __attribute__((ext_vector_type(4)));
typedef float f32x2 __attribute__((ext_vector_type(2)));
typedef unsigned u32x4 __attribute__((ext_vector_type(4)));
typedef unsigned u32x2 __attribute__((ext_vector_type(2)));

constexpr int D = 1024, MTP = 16384, MTS = 1024, MT = MTP + MTS, DG = 3072, DFF = 2816, SEQ = 2048;
constexpr float EPS = 1e-6f;
constexpr int NWAVES = 8, NTHR = 512;
constexpr int LDS_BYTES = 147456;
constexpr size_t O_Y = 0, O_PCONV = (size_t)MT * D, O_PH = O_PCONV + 8 * 3 * 1024, O_SCONV = O_PH + 8 * 1024, O_SH = O_SCONV + 128 * 3 * 1024, O_SV = O_SH + 128 * 1024;
constexpr size_t MiB = 1u << 20;
constexpr size_t WS_SP = 0;
constexpr size_t WS_BAR = 65536;
constexpr size_t WS_CNT = 262144;
constexpr size_t CNT_WORDS = (4 * 2 * 64 + 4 * 4) * 64;
constexpr size_t WS_FLG = WS_CNT + CNT_WORDS * 4;
constexpr size_t CTL_ZERO_BYTES = WS_FLG + 272 * 8 * 64 - WS_BAR;
static_assert(WS_FLG + 272 * 8 * 64 <= 1u << 20, "control region");
constexpr size_t WS_RSTD = 131072;
constexpr size_t WS_ST = 1 * MiB;
constexpr size_t WS_WG3 = 5 * MiB;
constexpr size_t WS_WF1 = 11 * MiB;
constexpr size_t WS_WF2 = 22 * MiB;
constexpr size_t WS_WF1B = WS_WF2 + 5632 * 1024;
constexpr size_t WS_WF2B = WS_WF1B + 11 * MiB;
constexpr size_t WS_WR1 = 44 * MiB;
constexpr size_t WS_WR2 = 48 * MiB;
constexpr size_t WS_WAX = 50 * MiB;
constexpr size_t WS_WSB = WS_WAX + 512 * 1024;
constexpr size_t WS_TS = WS_ST;
constexpr size_t WS_U = 52 * MiB;
constexpr size_t WS_V = 154 * MiB;
constexpr size_t DO_HN = 0, DO_WG1 = 36 * MiB;
static_assert((size_t)MT * D * 2 <= DO_WG1 && DO_WG1 + (size_t)6144 * 1024 * 2 <= (size_t)MT * D * 4, "d_out scratch");
static_assert(WS_TS + (size_t)272 * 1024 * 8 <= WS_WG3 && WS_WSB + 8 * 128 * 128 * 2 <= WS_U, "ts");
static_assert(WS_U + (size_t)MT * DG * 2 <= WS_V, "U region");
static_assert(WS_V + (size_t)MT * DG * 2 <= 256 * MiB, "V region");
static_assert(WS_ST + (size_t)24 * MT * 8 <= WS_WG3, "stats");

namespace pg8 {
constexpr int BM = 256, BK = 64, HALF = 128, HTB = HALF * BK * 2, STAGE_BYTES = 8 * HTB, NXCD = 8, WGM = 8;
__host__ __device__ __forceinline__ int lds_byte(int r, int c) { const int st = (r >> 4) * 2 + (c >> 5), rr = r & 15, cc = c & 31, ob = rr * 64 + cc * 2; return st * 1024 + (ob ^ (((ob >> 9) & 1) << 5)); }
__host__ __device__ __forceinline__ void stage_rc(int b, int& R, int& C) { const int st = b / 1024, sb = b % 1024, swz = sb ^ (((sb >> 9) & 1) << 5); R = (st >> 1) * 16 + swz / 64; C = (st & 1) * 32 + (swz % 64) / 2; }
__host__ __device__ __forceinline__ int perm32(int rho) { const int n = rho >> 4, i = rho & 15; return 8 * (i >> 2) + 4 * n + (i & 3); }

struct Unit { const char* a; const char* b; int pm, pn, kind, nt, ks; };
struct Sched {
    const char *A0, *B0, *A1, *B1; int nM0, nN0, nM1, nN1, n0, nwg, G, c, ntF; size_t tstep;
    __device__ __forceinline__ void init(const void* a0, const void* b0, int M0, int N0, const void* a1, const void* b1, int M1, int N1, int K, int G_, int c_) {
        A0 = (const char*)a0; B0 = (const char*)b0; A1 = (const char*)a1; B1 = (const char*)b1; nM0 = M0 / BM; nN0 = N0 / BM; nM1 = M1 / BM; nN1 = N1 / BM;
        n0 = nM0 * nN0; nwg = n0 + nM1 * nN1; G = G_; c = c_; ntF = K / BK; tstep = (size_t)BM * K * 2; }
    __device__ __forceinline__ bool next(int i, Unit& u) const {
        const long L = (long)i * G + c; if (L >= nwg) return false;
        int wgid = (int)L; { const int q = nwg / NXCD, r = nwg % NXCD, xcd = wgid % NXCD, off = wgid / NXCD; wgid = (xcd < r ? xcd * (q + 1) : r * (q + 1) + (xcd - r) * q) + off; }
        int kind = 0, nM = nM0, nN = nN0; const char* A = A0; const char* B = B0;
        if (wgid >= n0) { wgid -= n0; kind = 1; nM = nM1; nN = nN1; A = A1; B = B1; }
        const int nig = WGM * nN, gid = wgid / nig, fm = gid * WGM, gsz = (nM - fm) < WGM ? (nM - fm) : WGM;
        u.pm = fm + ((wgid % nig) % gsz); u.pn = (wgid % nig) / gsz; u.kind = kind; u.nt = ntF; u.ks = 0; u.a = A + (size_t)u.pm * tstep; u.b = B + (size_t)u.pn * tstep; return true;
    }
};
struct SchedTail {
    const char *A, *B; int G, c, ntF, NS; size_t tstep;
    __device__ __forceinline__ void init(const void* a, const void* b, int K, int NS_, int G_, int c_) { A = (const char*)a; B = (const char*)b; G = G_; c = c_; ntF = K / BK; NS = NS_; tstep = (size_t)BM * K * 2; }
    __device__ __forceinline__ bool next(int i, Unit& u) const {
        const int yy = (c >> 3) & 7; const bool has_sub = c < 256 && yy < (NS >> 1); const int ip = has_sub ? i - 1 : i, L = ip * G + c;
        if (ip >= 0) { if (L >= 256) return false;
            u.pm = 8 * (L & 7) + ((L >> 3) & 7); u.pn = L >> 6; u.kind = 0; u.nt = ntF; u.ks = 0; u.a = A + (size_t)u.pm * tstep; u.b = B + (size_t)u.pn * tstep; return true; }
        const int r = (c & 7) + 8 * (yy + (NS >> 1) * (c >> 6));
        const int ks = r % NS, t = r / NS, hp = ntF >> 1, p0 = ks * hp / NS, p1 = (ks + 1) * hp / NS;
        u.pm = 64 + (t >> 2); u.pn = t & 3; u.kind = 1; u.ks = ks; u.nt = 2 * (p1 - p0);
        u.a = A + (size_t)u.pm * tstep + (size_t)p0 * (4 * BK); u.b = B + (size_t)u.pn * tstep + (size_t)p0 * (4 * BK); return true;
    }
};

__device__ __forceinline__ unsigned cvt_pk_bf16(float lo, float hi) { unsigned r; asm volatile("v_cvt_pk_bf16_f32 %0, %1, %2" : "=v"(r) : "v"(lo), "v"(hi)); return r; }
__device__ __forceinline__ float gelu_t(float x) {
    const float y = x * (1.0f + 0.044715f * x * x) * (-1.5957691216f * 1.4426950409f);
    return x * __builtin_amdgcn_rcpf(1.0f + __builtin_amdgcn_exp2f(y));
}
__device__ __forceinline__ float sigmoid_f(float x) { return __builtin_amdgcn_rcpf(1.0f + __builtin_amdgcn_exp2f(x * -1.4426950409f)); }
__device__ __forceinline__ f32x2 gelu2(f32x2 x) {
    const f32x2 t = (x * x) * (0.044715f * -1.5957691216f * 1.4426950409f) + (-1.5957691216f * 1.4426950409f), y = x * t;
    f32x2 e; e.x = __builtin_amdgcn_exp2f(y.x); e.y = __builtin_amdgcn_exp2f(y.y);
    const f32x2 d = e + 1.0f; f32x2 r; r.x = __builtin_amdgcn_rcpf(d.x); r.y = __builtin_amdgcn_rcpf(d.y);
    return x * r;
}
__device__ __forceinline__ f32x2 silu_mul2(f32x2 g, f32x2 u) {
    const f32x2 y = g * -1.4426950409f; f32x2 e; e.x = __builtin_amdgcn_exp2f(y.x); e.y = __builtin_amdgcn_exp2f(y.y);
    const f32x2 d = e + 1.0f; f32x2 r; r.x = __builtin_amdgcn_rcpf(d.x); r.y = __builtin_amdgcn_rcpf(d.y);
    return (g * r) * u;
}
__device__ __forceinline__ float rstd16(const float* p4) {
    const f32x4 t = *(const f32x4*)p4; return __builtin_amdgcn_rsqf(((t[0] + t[1]) + (t[2] + t[3])) * (1.f / D) + EPS); }
__device__ __forceinline__ f32x4 gelu4s(f32x4 v) { return (f32x4){gelu_t(v[0]), gelu_t(v[1]), gelu_t(v[2]), gelu_t(v[3])}; }
__device__ __forceinline__ f32x4 gelu4(f32x4 v) { const f32x2 a = gelu2((f32x2){v[0], v[1]}), b = gelu2((f32x2){v[2], v[3]}); return (f32x4){a.x, a.y, b.x, b.y}; }

template <int ACT> __device__ __forceinline__ void store_tile_bf16(const f32x4 (&acc)[2][2][4][2], int pm, int coltile, bf16_t* O, int ldc, const float* bias  , int wr, int wc, int fr, int fq, const float* rs = nullptr  , bool rs16 = false  ) {
    const int row0 = pm * BM + wr * 64 + fr, col0 = coltile + wc * 32 + 8 * fq;
    f32x4 bv[2][2];
#pragma unroll
    for (int bj = 0; bj < 2; ++bj)
#pragma unroll
        for (int n = 0; n < 2; ++n) bv[bj][n] = bias ? *(const f32x4*)(bias + wc * 32 + 8 * fq + bj * HALF + 4 * n) : (f32x4){0.f, 0.f, 0.f, 0.f};
#pragma unroll
    for (int ai = 0; ai < 2; ++ai)
#pragma unroll
        for (int m = 0; m < 4; ++m) { bf16_t* rowp = O + (size_t)(row0 + ai * HALF + m * 16) * ldc + col0; const float rsv = rs ? (rs16 ? rstd16(rs + (size_t)(row0 + ai * HALF + m * 16) * 4) : rs[row0 + ai * HALF + m * 16]) : 1.0f;
#pragma unroll
            for (int bj = 0; bj < 2; ++bj) { f32x4 v0 = acc[ai][bj][m][0] * rsv + bv[bj][0], v1 = acc[ai][bj][m][1] * rsv + bv[bj][1];
                if (ACT == 1) { v0 = gelu4s(v0); v1 = gelu4s(v1); }
                if (ACT == 2) { v0 = gelu4(v0); v1 = gelu4(v1); }
                u32x4 w; w.x = cvt_pk_bf16(v0[0], v0[1]); w.y = cvt_pk_bf16(v0[2], v0[3]); w.z = cvt_pk_bf16(v1[0], v1[1]); w.w = cvt_pk_bf16(v1[2], v1[3]);
                *(u32x4*)(rowp + bj * HALF) = w; } }
}

struct EpiPlain {
    bf16_t* O; int ldc;
    __device__ __forceinline__ void operator()(const f32x4 (&acc)[2][2][4][2], const Unit& u, int wr, int wc, int fr, int fq) const { store_tile_bf16<0>(acc, u.pm, u.pn * BM, O, ldc, nullptr, wr, wc, fr, fq); }
};
struct EpiTail {
    bf16_t* O; float* PB;
    __device__ __forceinline__ void operator()(const f32x4 (&acc)[2][2][4][2], const Unit& u, int wr, int wc, int fr, int fq) const {
        if (u.kind == 0) { store_tile_bf16<0>(acc, u.pm, u.pn * BM, O, D, nullptr, wr, wc, fr, fq); return; }
        float* base = PB + (size_t)u.ks * (MTS * D) + (size_t)((u.pm - 64) * BM + wr * 64 + fr) * D + u.pn * BM + wc * 32 + 8 * fq;
#pragma unroll
        for (int ai = 0; ai < 2; ++ai)
#pragma unroll
            for (int m = 0; m < 4; ++m)
#pragma unroll
                for (int bj = 0; bj < 2; ++bj) { float* p = base + (size_t)(ai * HALF + m * 16) * D + bj * HALF; *(f32x4*)p = acc[ai][bj][m][0]; *(f32x4*)(p + 4) = acc[ai][bj][m][1]; }
    }
};
struct RmsExchange {
    float* xbuf; unsigned* cnt;
    __device__ __forceinline__ void publish(const f32x4 (&v)[2][2][4][2], int pm, int pn, int wr, int wc, int fr, int fq, LAS unsigned char* lds) const {
        LAS float* P = (LAS float*)lds;
        const int wid = wr * 4 + wc, lane = fq * 16 + fr;
#pragma unroll
        for (int ai = 0; ai < 2; ++ai)
#pragma unroll
            for (int m = 0; m < 4; ++m) { float s = 0.f;
#pragma unroll
                for (int bj = 0; bj < 2; ++bj)
#pragma unroll
                    for (int n = 0; n < 2; ++n) { const f32x4 x = v[ai][bj][m][n]; s += (x[0] * x[0] + x[1] * x[1]) + (x[2] * x[2] + x[3] * x[3]); }
                s += __shfl_xor(s, 16); s += __shfl_xor(s, 32);
                if (fq == 0) P[(ai * HALF + wr * 64 + m * 16 + fr) * 4 + wc] = s; }
        asm volatile("s_waitcnt lgkmcnt(0)" ::: "memory"); __builtin_amdgcn_s_barrier(); asm volatile("" ::: "memory");
        const int row = wid * 32 + (lane & 31);
        if (lane < 32) { const float t = (P[row * 4 + 0] + P[row * 4 + 1]) + (P[row * 4 + 2] + P[row * 4 + 3]);
            __hip_atomic_store(xbuf + ((size_t)(pm * BM + row) * 4 + pn), t, __ATOMIC_RELAXED, __HIP_MEMORY_SCOPE_AGENT); }
        asm volatile("s_waitcnt vmcnt(0)" ::: "memory");
        if (lane == 0) __hip_atomic_fetch_add(cnt + 64 * pm, 1u, __ATOMIC_RELAXED, __HIP_MEMORY_SCOPE_AGENT);
    }
    __device__ __forceinline__ void wait(int pm, int pn, int wr, int wc, int fr, int fq, LAS unsigned char* lds, float* rstd_out  ) const {
        LAS float* S = (LAS float*)(lds + 4096);
        const int wid = wr * 4 + wc, lane = fq * 16 + fr, row = wid * 32 + (lane & 31);
        if (wid == 0) { unsigned sp = 0;
            while ((unsigned)__builtin_amdgcn_readfirstlane(__hip_atomic_load(cnt + 64 * pm, __ATOMIC_RELAXED, __HIP_MEMORY_SCOPE_AGENT)) < 32u) { __builtin_amdgcn_s_sleep(2); if (++sp > (1u << 22)) break; }
            __builtin_amdgcn_fence(__ATOMIC_ACQUIRE, "agent"); }
        asm volatile("s_waitcnt vmcnt(0) lgkmcnt(0)" ::: "memory"); __builtin_amdgcn_s_barrier(); asm volatile("" ::: "memory");
        if (lane < 32) { const float* slot = xbuf + (size_t)(pm * BM + row) * 4; float t = 0.f;
#pragma unroll
            for (int k = 0; k < 4; ++k) t += __hip_atomic_load(slot + k, __ATOMIC_RELAXED, __HIP_MEMORY_SCOPE_AGENT);
            const float rs = __builtin_amdgcn_rsqf(t * (1.f / D) + EPS); S[row] = rs;
            if (rstd_out && pn == 0) rstd_out[pm * BM + row] = rs; }
        asm volatile("s_waitcnt lgkmcnt(0)" ::: "memory"); __builtin_amdgcn_s_barrier(); asm volatile("" ::: "memory");
    }
};
template <bool FINAL> struct EpiTailFused {
    bf16_t* PB; unsigned* scnt  ; RmsExchange e1; const bf16_t* XBin  ; bf16_t* XB  ; const float* g1; float* outf; float* RSTD  ; LAS unsigned char* ldsx;
    static __device__ __forceinline__ void unpack8(f32x4& a, f32x4& b, u32x4 w) {
        a = (f32x4){__builtin_bit_cast(float, w.x << 16), __builtin_bit_cast(float, w.x & 0xffff0000u), __builtin_bit_cast(float, w.y << 16), __builtin_bit_cast(float, w.y & 0xffff0000u)};
        b = (f32x4){__builtin_bit_cast(float, w.z << 16), __builtin_bit_cast(float, w.z & 0xffff0000u), __builtin_bit_cast(float, w.w << 16), __builtin_bit_cast(float, w.w & 0xffff0000u)}; }
    __device__ __forceinline__ void operator()(f32x4 (&acc)[2][2][4][2], const Unit& u, int wr, int wc, int fr, int fq) const {
        if (u.kind == 1) {
            bf16_t* base = PB + (size_t)u.ks * (MTS * D) + (size_t)((u.pm - 64) * BM + wr * 64 + fr) * D + u.pn * BM + wc * 32 + 8 * fq;
#pragma unroll
            for (int ai = 0; ai < 2; ++ai)
#pragma unroll
                for (int m = 0; m < 4; ++m)
#pragma unroll
                    for (int bj = 0; bj < 2; ++bj) { const f32x4 v0 = acc[ai][bj][m][0], v1 = acc[ai][bj][m][1]; u32x4 w; w.x = cvt_pk_bf16(v0[0], v0[1]); w.y = cvt_pk_bf16(v0[2], v0[3]); w.z = cvt_pk_bf16(v1[0], v1[1]); w.w = cvt_pk_bf16(v1[2], v1[3]);
                        *(u32x4*)(base + (size_t)(ai * HALF + m * 16) * D + bj * HALF) = w; }
            asm volatile("s_waitcnt vmcnt(0)" ::: "memory"); __builtin_amdgcn_s_barrier(); asm volatile("" ::: "memory");
            if (threadIdx.x == 0) { __builtin_amdgcn_fence(__ATOMIC_RELEASE, "agent"); asm volatile("s_waitcnt vmcnt(0)" ::: "memory");
                __hip_atomic_fetch_add(scnt + 64 * (u.pm - 64), 1u, __ATOMIC_RELAXED, __HIP_MEMORY_SCOPE_AGENT); }
            return; }
        const LAS float* S = (const LAS float*)(ldsx + 4096);
        const int col0 = u.pn * BM + wc * 32 + 8 * fq;
        e1.publish(acc, u.pm, u.pn, wr, wc, fr, fq, ldsx);
        u32x4 pre[4][2];
#pragma unroll
        for (int m = 0; m < 4; ++m)
#pragma unroll
            for (int bj = 0; bj < 2; ++bj) pre[m][bj] = *(const u32x4*)(XBin + (size_t)(u.pm * BM + wr * 64 + m * 16 + fr) * D + col0 + bj * HALF);
        f32x4 gv[2][2];
#pragma unroll
        for (int bj = 0; bj < 2; ++bj)
#pragma unroll
            for (int n = 0; n < 2; ++n) gv[bj][n] = *(const f32x4*)(g1 + col0 + bj * HALF + 4 * n);
        e1.wait(u.pm, u.pn, wr, wc, fr, fq, ldsx, nullptr);
#pragma unroll
        for (int ai = 0; ai < 2; ++ai)
#pragma unroll
            for (int m = 0; m < 4; ++m) { const int row = ai * HALF + wr * 64 + m * 16 + fr; const float rs = S[row]; const size_t off = (size_t)(u.pm * BM + row) * D + col0; float s2 = 0.f;
#pragma unroll
                for (int bj = 0; bj < 2; ++bj) { f32x4 x0, x1; unpack8(x0, x1, ai == 0 ? pre[m][bj] : *(const u32x4*)(XBin + off + bj * HALF));
                    const f32x4 v0 = x0 + acc[ai][bj][m][0] * rs * gv[bj][0], v1 = x1 + acc[ai][bj][m][1] * rs * gv[bj][1];
                    s2 += ((v0[0] * v0[0] + v0[1] * v0[1]) + (v0[2] * v0[2] + v0[3] * v0[3])) + ((v1[0] * v1[0] + v1[1] * v1[1]) + (v1[2] * v1[2] + v1[3] * v1[3]));
                    if (FINAL) { *(f32x4*)(outf + off + bj * HALF) = v0; *(f32x4*)(outf + off + bj * HALF + 4) = v1; }
                    else { u32x4 w; w.x = cvt_pk_bf16(v0[0], v0[1]); w.y = cvt_pk_bf16(v0[2], v0[3]); w.z = cvt_pk_bf16(v1[0], v1[1]); w.w = cvt_pk_bf16(v1[2], v1[3]); *(u32x4*)(XB + off + bj * HALF) = w; } }
                if (!FINAL) { s2 += __shfl_xor(s2, 16); s2 += __shfl_xor(s2, 32);
                    if (fq == 0) ((LAS float*)ldsx)[row * 4 + wc] = s2; }
                if (m == 3) asm volatile("" ::: "memory"); }
        if (!FINAL) {
            asm volatile("s_waitcnt lgkmcnt(0)" ::: "memory"); __builtin_amdgcn_s_barrier(); asm volatile("" ::: "memory");
            const int wid = wr * 4 + wc, lane = fq * 16 + fr, row = wid * 32 + (lane & 31); const LAS float* P = (const LAS float*)ldsx;
            if (lane < 32) RSTD[(size_t)(u.pm * BM + row) * 4 + u.pn] = (P[row * 4 + 0] + P[row * 4 + 1]) + (P[row * 4 + 2] + P[row * 4 + 3]);
            asm volatile("s_waitcnt lgkmcnt(0)" ::: "memory"); __builtin_amdgcn_s_barrier(); asm volatile("" ::: "memory");
        }
    }
};
struct EpiG6 {
    bf16_t* GATE; bf16_t* XBR; const float* rs;
    __device__ __forceinline__ void operator()(const f32x4 (&acc)[2][2][4][2], const Unit& u, int wr, int wc, int fr, int fq) const {
        if (u.pn < 4) store_tile_bf16<2>(acc, u.pm, u.pn * BM, GATE, D, nullptr, wr, wc, fr, fq, rs, true);
        else store_tile_bf16<0>(acc, u.pm, (u.pn - 4) * BM, XBR, D, nullptr, wr, wc, fr, fq, rs, true);
    }
};
struct EpiSwiglu {
    bf16_t* H; const float* rs;
    __device__ __forceinline__ void operator()(const f32x4 (&acc)[2][2][4][2], const Unit& u, int wr, int wc, int fr, int fq) const {
        const int row0 = u.pm * BM + wr * 64 + fr, col0 = u.pn * HALF + wc * 32 + 8 * fq;
#pragma unroll
        for (int ai = 0; ai < 2; ++ai)
#pragma unroll
            for (int m = 0; m < 4; ++m) { bf16_t* rowp = H + (size_t)(row0 + ai * HALF + m * 16) * DFF + col0; f32x4 o[2]; const float rsv = rstd16(rs + (size_t)(row0 + ai * HALF + m * 16) * 4);
#pragma unroll
                for (int n = 0; n < 2; ++n) { const f32x4 g = acc[ai][0][m][n] * rsv, uu = acc[ai][1][m][n] * rsv;
                    const f32x2 a = silu_mul2((f32x2){g[0], g[1]}, (f32x2){uu[0], uu[1]}), b = silu_mul2((f32x2){g[2], g[3]}, (f32x2){uu[2], uu[3]}); o[n] = (f32x4){a.x, a.y, b.x, b.y}; }
                u32x4 w; w.x = cvt_pk_bf16(o[0][0], o[0][1]); w.y = cvt_pk_bf16(o[0][2], o[0][3]); w.z = cvt_pk_bf16(o[1][0], o[1][1]); w.w = cvt_pk_bf16(o[1][2], o[1][3]);
                *(u32x4*)rowp = w; }
    }
};
__device__ __forceinline__ float row16_sum_lane0(float v) {
    v += __builtin_bit_cast(float, __builtin_amdgcn_update_dpp(0, __builtin_bit_cast(int, v), 0x108, 0xf, 0xf, true));
    v += __builtin_bit_cast(float, __builtin_amdgcn_update_dpp(0, __builtin_bit_cast(int, v), 0x104, 0xf, 0xf, true));
    v += __builtin_bit_cast(float, __builtin_amdgcn_update_dpp(0, __builtin_bit_cast(int, v), 0x102, 0xf, 0xf, true));
    v += __builtin_bit_cast(float, __builtin_amdgcn_update_dpp(0, __builtin_bit_cast(int, v), 0x101, 0xf, 0xf, true));
    return v;
}
struct EpiG1 {
    bf16_t* U; bf16_t* VT; const float* b_in; f32x2* ST; const float* rs;
    __device__ __forceinline__ void operator()(const f32x4 (&acc)[2][2][4][2], const Unit& u, int wr, int wc, int fr, int fq) const {
        if (u.kind == 0) { store_tile_bf16<2>(acc, u.pm, u.pn * BM, U, DG, b_in + u.pn * BM, wr, wc, fr, fq, rs); return; }
        const int row0 = u.pm * BM + wr * 64 + fr, col0 = u.pn * BM + wc * 32 + 8 * fq;
#pragma unroll
        for (int bj = 0; bj < 2; ++bj) {
            float cs[2][4], cq[2][4]; const f32x4 rc0 = *(const f32x4*)(rs + col0 + bj * HALF), rc1 = *(const f32x4*)(rs + col0 + bj * HALF + 4);
#pragma unroll
            for (int n = 0; n < 2; ++n)
#pragma unroll
                for (int j = 0; j < 4; ++j) { cs[n][j] = 0.f; cq[n][j] = 0.f; }
#pragma unroll
            for (int ai = 0; ai < 2; ++ai)
#pragma unroll
                for (int m = 0; m < 4; ++m) { const int row = row0 + ai * HALF + m * 16; const float bv = b_in[DG + row]; bf16_t* rowp = VT + (size_t)row * MT + col0 + bj * HALF;
                    { const f32x4 v0 = gelu4s(acc[ai][bj][m][0] * rc0 + bv);
#pragma unroll
                      for (int j = 0; j < 4; ++j) { cs[0][j] += v0[j]; cq[0][j] += v0[j] * v0[j]; }
                      u32x2 w; w.x = cvt_pk_bf16(v0[0], v0[1]); w.y = cvt_pk_bf16(v0[2], v0[3]); *(u32x2*)rowp = w; }
                    { const f32x4 v1 = gelu4s(acc[ai][bj][m][1] * rc1 + bv);
#pragma unroll
                      for (int j = 0; j < 4; ++j) { cs[1][j] += v1[j]; cq[1][j] += v1[j] * v1[j]; }
                      u32x2 w; w.x = cvt_pk_bf16(v1[0], v1[1]); w.y = cvt_pk_bf16(v1[2], v1[3]); *(u32x2*)(rowp + 4) = w; } }
#pragma unroll
            for (int n = 0; n < 2; ++n) {
#pragma unroll
                for (int j = 0; j < 4; ++j) { cs[n][j] = row16_sum_lane0(cs[n][j]); cq[n][j] = row16_sum_lane0(cq[n][j]); }
                if (fr == 0) { f32x2* sp = ST + (size_t)(u.pm * 2 + wr) * MT + col0 + bj * HALF + 4 * n;
                    *(f32x4*)(sp) = (f32x4){cs[n][0], cq[n][0], cs[n][1], cq[n][1]};
                    *(f32x4*)(sp + 2) = (f32x4){cs[n][2], cq[n][2], cs[n][3], cq[n][3]}; } }
            asm volatile("" ::: "memory");
        }
    }
};

template <class Epi, class SchedT>
__device__ __forceinline__ void gemm_phase(LAS unsigned char* lds, const int K, const SchedT& S, const Epi& E) {
    const int tid = threadIdx.x, wid = __builtin_amdgcn_readfirstlane(tid >> 6), lane = tid & 63, wr = wid >> 2, wc = wid & 3, fr = lane & 15, fq = lane >> 4;
    unsigned voffA[2], voffB[2];
#pragma unroll
    for (int i = 0; i < 2; ++i) { int R, C; stage_rc(tid * 16 + i * 8192, R, C); const int Rb = (R & ~31) + perm32(R & 31);
        voffA[i] = (unsigned)(R * K + C) * 2u; voffB[i] = (unsigned)(Rb * K + C) * 2u; }
    const size_t kstep = (size_t)(BK * 2);
    const size_t hstep = (size_t)HALF * K * 2;
    const unsigned ldsw = (unsigned)wid * 1024u;
    const int aoff = lds_byte(wr * 64 + fr, fq * 8), boff = lds_byte(wc * 32 + fr, fq * 8);
#define PG8_SA(b, h) (((b) * 2 + (h)) * HTB)
#define PG8_SB(b, h) ((4 + (b) * 2 + (h)) * HTB)
#define PG8_STAGE(bufoff, gbase, voff) do { _Pragma("unroll") for (int _i = 0; _i < 2; ++_i) \
        __builtin_amdgcn_global_load_lds((const unsigned*)((const char*)(gbase) + (voff)[_i]), (LAS unsigned*)(lds + (bufoff) + ldsw + _i * 8192), 16, 0, 0); } while (0)
#define PG8_LDA(dst, b, h) do { _Pragma("unroll") for (int m = 0; m < 4; ++m) _Pragma("unroll") for (int k = 0; k < 2; ++k) dst[m][k] = *(const LAS bf16x8*)(lds + PG8_SA(b, h) + aoff + m * 2048 + k * 1024); } while (0)
#define PG8_LDB(dst, b, h) do { _Pragma("unroll") for (int n = 0; n < 2; ++n) _Pragma("unroll") for (int k = 0; k < 2; ++k) dst[n][k] = *(const LAS bf16x8*)(lds + PG8_SB(b, h) + boff + n * 2048 + k * 1024); } while (0)
#define PG8_MMA(ai, bj, At, Bt) do { __builtin_amdgcn_s_setprio(1); _Pragma("unroll") for (int m = 0; m < 4; ++m) _Pragma("unroll") for (int n = 0; n < 2; ++n) _Pragma("unroll") for (int k = 0; k < 2; ++k) \
        acc[ai][bj][m][n] = __builtin_amdgcn_mfma_f32_16x16x32_bf16(Bt[n][k], At[m][k], acc[ai][bj][m][n], 0, 0, 0); __builtin_amdgcn_s_setprio(0); } while (0)
#define PG8_WAIT_V(n) asm volatile("s_waitcnt vmcnt(" #n ")" ::: "memory")
#define PG8_WAIT_L(n) asm volatile("s_waitcnt lgkmcnt(" #n ")" ::: "memory")
#define PG8_BAR __builtin_amdgcn_s_barrier()
#define PG8_SCHED __builtin_amdgcn_sched_barrier(0)
    Unit cur, nxt; int ui = 0;
    if (!S.next(0, cur)) return;
    f32x4 acc[2][2][4][2];
#pragma unroll
    for (int a = 0; a < 2; ++a)
#pragma unroll
        for (int b = 0; b < 2; ++b)
#pragma unroll
            for (int m = 0; m < 4; ++m)
#pragma unroll
                for (int n = 0; n < 2; ++n) acc[a][b][m][n] = (f32x4){0.f, 0.f, 0.f, 0.f};
    bf16x8 At[4][2], B0[2][2], B1[2][2];
    const char* cA = cur.a; const char* cB = cur.b;
    PG8_WAIT_V(0);
    PG8_STAGE(PG8_SB(0, 0), cB, voffB); PG8_STAGE(PG8_SB(0, 1), cB + hstep, voffB); PG8_STAGE(PG8_SA(0, 0), cA, voffA); PG8_STAGE(PG8_SA(0, 1), cA + hstep, voffA);
    if (wr == 1) PG8_BAR;
    PG8_WAIT_V(2); PG8_BAR;
    PG8_STAGE(PG8_SB(1, 0), cB + kstep, voffB); PG8_STAGE(PG8_SA(1, 0), cA + kstep, voffA); PG8_STAGE(PG8_SB(1, 1), cB + hstep + kstep, voffB);
    PG8_WAIT_V(6); PG8_BAR;
    for (;;) {
        const bool has_next = S.next(ui + 1, nxt); const int nt = cur.nt;
        const char* nA = has_next ? nxt.a : cA; const char* nB = has_next ? nxt.b : cB;
        for (int t = 0; t < nt; t += 2) {
            const bool last = (t == nt - 2);
            const char* a1 = cA + (size_t)(t + 1) * kstep;
            const char* a2 = last ? nA : cA + (size_t)(t + 2) * kstep; const char* b2 = last ? nB : cB + (size_t)(t + 2) * kstep;
            const char* a3 = a2 + kstep; const char* b3 = b2 + kstep;
            PG8_LDB(B0, 0, 0); PG8_LDB(B1, 0, 1); PG8_SCHED; PG8_LDA(At, 0, 0); PG8_STAGE(PG8_SA(1, 1), a1 + hstep, voffA);
            PG8_WAIT_V(8); PG8_WAIT_L(0); PG8_BAR; PG8_MMA(0, 0, At, B0); PG8_MMA(0, 1, At, B1); PG8_BAR; PG8_SCHED;
            PG8_LDA(At, 0, 1); PG8_STAGE(PG8_SB(0, 0), b2, voffB); PG8_STAGE(PG8_SB(0, 1), b2 + hstep, voffB); PG8_STAGE(PG8_SA(0, 0), a2, voffA);
            PG8_WAIT_V(8); PG8_WAIT_L(0); PG8_BAR; PG8_MMA(1, 0, At, B0); PG8_MMA(1, 1, At, B1); PG8_BAR; PG8_SCHED;
            PG8_LDB(B0, 1, 0); PG8_LDB(B1, 1, 1); PG8_SCHED; PG8_LDA(At, 1, 0); PG8_STAGE(PG8_SA(0, 1), a2 + hstep, voffA);
            PG8_WAIT_V(8); PG8_WAIT_L(0); PG8_BAR; PG8_MMA(0, 0, At, B0); PG8_MMA(0, 1, At, B1); PG8_BAR; PG8_SCHED;
            PG8_LDA(At, 1, 1); PG8_STAGE(PG8_SB(1, 0), b3, voffB); PG8_STAGE(PG8_SB(1, 1), b3 + hstep, voffB); PG8_STAGE(PG8_SA(1, 0), a3, voffA);
            PG8_WAIT_V(8); PG8_WAIT_L(0); PG8_BAR; PG8_MMA(1, 0, At, B0); PG8_MMA(1, 1, At, B1); PG8_BAR; PG8_SCHED;
        }
        if (wr == 0) PG8_BAR;
        E(acc, cur, wr, wc, fr, fq);
        if (!has_next) break;
#pragma unroll
        for (int a = 0; a < 2; ++a)
#pragma unroll
            for (int b = 0; b < 2; ++b)
#pragma unroll
                for (int m = 0; m < 4; ++m)
#pragma unroll
                    for (int n = 0; n < 2; ++n) acc[a][b][m][n] = (f32x4){0.f, 0.f, 0.f, 0.f};
        cur = nxt; cA = nA; cB = nB; ++ui;
        if (wr == 1) PG8_BAR;
    }
    PG8_WAIT_V(0);
    PG8_BAR;
#undef PG8_SA
#undef PG8_SB
#undef PG8_STAGE
#undef PG8_LDA
#undef PG8_LDB
#undef PG8_MMA
#undef PG8_WAIT_V
#undef PG8_WAIT_L
#undef PG8_BAR
#undef PG8_SCHED
}
}

#define LDS_WAIT() asm volatile("s_waitcnt lgkmcnt(0)" ::: "memory")
__device__ __forceinline__ unsigned f2bf(float f) { unsigned u = __builtin_bit_cast(unsigned, f); return (u + 0x7fffu + ((u >> 16) & 1u)) >> 16; }
__device__ __forceinline__ unsigned pk2(float lo, float hi) { return pg8::cvt_pk_bf16(lo, hi); }
__device__ __forceinline__ bf16_t f2bf1(float f) { return (bf16_t)(pg8::cvt_pk_bf16(f, f) & 0xffffu); }
__device__ __forceinline__ float bflo(unsigned w) { return __builtin_bit_cast(float, w << 16); }
__device__ __forceinline__ float bfhi(unsigned w) { return __builtin_bit_cast(float, w & 0xffff0000u); }
__device__ __forceinline__ float wave_sum(float v) {
#pragma unroll
    for (int o = 1; o < 64; o <<= 1) v += __shfl_xor(v, o);
    return v;
}

#define XB_TMO      128
#define XB_XCNT(j)  (256  + 64 * (j))
#define XB_XSUB(j)  (1280 + 64 * (j))
#define XB_XGEN(j)  (2304 + 64 * (j))
#define XB_TOP      3328
#define XB_TOPGEN   3392
#define XCD_BAR_WORDS 3456
#define XB_SPIN_CAP (1u << 18)

__device__ __forceinline__ unsigned xb_ld(unsigned* p)              { return __hip_atomic_load(p, __ATOMIC_RELAXED, __HIP_MEMORY_SCOPE_AGENT); }
__device__ __forceinline__ unsigned xb_add(unsigned* p, unsigned v) { return __hip_atomic_fetch_add(p, v, __ATOMIC_RELAXED, __HIP_MEMORY_SCOPE_AGENT); }
__device__ __forceinline__ unsigned xb_xcc_id() { return (unsigned)__builtin_amdgcn_s_getreg((3 << 11) | 20) & 0xFu; }
#define XB_SPIN(cond, bar) do { unsigned _sp = 0; while (cond) { __builtin_amdgcn_s_sleep(1); \
    if ((++_sp & 255u) == 0u) { if (xb_ld(&(bar)[XB_TMO])) break; if (_sp > XB_SPIN_CAP) { atomicAdd(&(bar)[XB_TMO], 1u); break; } } } } while (0)

struct XcdBarrier {
    unsigned* bar; unsigned x;
    volatile LAS unsigned* st;
};

__device__ __forceinline__ XcdBarrier xcd_barrier_post(unsigned* bar, volatile LAS unsigned* st) {
    XcdBarrier b; b.bar = bar; b.x = xb_xcc_id(); b.st = st;
    if (threadIdx.x == 0) (void)xb_add(&bar[XB_XCNT(b.x)], 1u);
    return b;
}
__device__ __forceinline__ void xcd_barrier_complete(unsigned* bar, unsigned x, unsigned& nloc, unsigned& nx) {
    const unsigned G = gridDim.x * gridDim.y * gridDim.z;
    unsigned sum, cnt, mine, sp = 0u;
    for (;;) {
        sum = 0u; cnt = 0u; mine = 0u;
#pragma unroll
        for (unsigned j = 0; j < 16; ++j) { const unsigned c = xb_ld(&bar[XB_XCNT(j)]); sum += c; cnt += (c > 0u) ? 1u : 0u; mine = (j == x) ? c : mine; }
        if (sum == G) break;
        __builtin_amdgcn_s_sleep(1);
        if ((++sp & 255u) == 0u) { if (xb_ld(&bar[XB_TMO])) break; if (sp > XB_SPIN_CAP) { atomicAdd(&bar[XB_TMO], 1u); break; } }
    }
    nloc = mine > 0u ? mine : 1u; nx = cnt > 0u ? cnt : 1u;
}

__device__ __forceinline__ void xcd_barrier(const XcdBarrier& b) {
    asm volatile("s_waitcnt vmcnt(0)" ::: "memory");
    __syncthreads();
    if (threadIdx.x == 0) {
        unsigned* bar = b.bar;
        __builtin_amdgcn_s_waitcnt(0);
        unsigned nloc = b.st[0], nx = b.st[1];
        if (nloc == 0u) { xcd_barrier_complete(bar, b.x, nloc, nx); b.st[0] = nloc; b.st[1] = nx; }
        const unsigned old = xb_add(&bar[XB_XSUB(b.x)], 1u);
        const unsigned gen = old / nloc;
        if (old + 1u == (gen + 1u) * nloc) {
            __builtin_amdgcn_fence(__ATOMIC_RELEASE, "agent");
            asm volatile("s_waitcnt vmcnt(0)" ::: "memory");
            const unsigned og = xb_add(&bar[XB_TOP], 1u);
            const unsigned tg = og / nx;
            if (og + 1u == (tg + 1u) * nx) xb_add(&bar[XB_TOPGEN], 1u);
            else XB_SPIN(xb_ld(&bar[XB_TOPGEN]) == tg, bar);
            __builtin_amdgcn_fence(__ATOMIC_ACQUIRE, "agent");
            xb_add(&bar[XB_XGEN(b.x)], 1u);
            asm volatile("s_waitcnt vmcnt(0)" ::: "memory");
        } else {
            XB_SPIN(xb_ld(&bar[XB_XGEN(b.x)]) == gen, bar);
            __builtin_amdgcn_fence(__ATOMIC_ACQUIRE, "agent");
            asm volatile("s_waitcnt vmcnt(0)" ::: "memory");
        }
    }
    __syncthreads();
}


struct Ctx {
    LAS unsigned char* lds; int tid, lane, wave, vcu, G;
    float* out; unsigned char* ws;
};
struct Args { const float* in[23]; float* out; unsigned char* ws; int ph_lo, ph_hi; };
#define CIN(k) (A.in[k])

template <int MAP> __device__ __forceinline__ void p0_transpose_item(const float* W, int K, int N, bf16_t* WT, int row_off, LAS float* scr, int item, int lane, const float* gk = nullptr  ) {
    const int nblk = N / 32, kb = item / nblk, nb = item % nblk, k0 = 64 * kb, n0 = 32 * nb;
#pragma unroll 8
    for (int i = 0; i < 32; ++i) { const int kk = 2 * i + (lane >> 5); scr[kk * 33 + (lane & 31)] = W[(size_t)(k0 + kk) * N + n0 + (lane & 31)] * (gk ? gk[k0 + kk] : 1.0f); }
    LDS_WAIT(); asm volatile("" ::: "memory");
    int r0 = row_off + n0;
    if (MAP == 1) { const int half = n0 / DFF, f = n0 % DFF; r0 = (f / 128) * 256 + half * 128 + (f % 128); }
    const int c = lane & 7;
#pragma unroll
    for (int j = 0; j < 4; ++j) { const int n = (lane >> 3) + 8 * j; const LAS float* s = scr + (8 * c) * 33 + n;
        u32x4 o; o.x = pk2(s[0 * 33], s[1 * 33]); o.y = pk2(s[2 * 33], s[3 * 33]); o.z = pk2(s[4 * 33], s[5 * 33]); o.w = pk2(s[6 * 33], s[7 * 33]);
        *(u32x4*)(WT + (size_t)(r0 + n) * K + k0 + 8 * c) = o; }
    LDS_WAIT(); asm volatile("" ::: "memory");
}

__device__ __forceinline__ void ld8_bf16(f32x4& a, f32x4& b, const bf16_t* p) { const u32x4 w = *(const u32x4*)p; a = (f32x4){bflo(w.x), bfhi(w.x), bflo(w.y), bfhi(w.y)}; b = (f32x4){bflo(w.z), bfhi(w.z), bflo(w.w), bfhi(w.w)}; }
template <bool XIN_F32, bool HAS_MM> __device__ __forceinline__ void row_load(f32x4 (&v)[4], f32x4 (&m)[4], const void* xin, const bf16_t* mm, const bf16_t* pb, int ns, int lane) {
#pragma unroll
    for (int j = 0; j < 2; ++j) { const int e = 8 * lane + 512 * j;
        if (XIN_F32) { v[2 * j] = *(const f32x4*)((const float*)xin + e); v[2 * j + 1] = *(const f32x4*)((const float*)xin + e + 4); }
        else ld8_bf16(v[2 * j], v[2 * j + 1], (const bf16_t*)xin + e); }
    if (HAS_MM) {
#pragma unroll
        for (int j = 0; j < 2; ++j) { const int e = 8 * lane + 512 * j;
            if (pb) { ld8_bf16(m[2 * j], m[2 * j + 1], pb + e);
                for (int k = 1; k < ns; ++k) { f32x4 a, b; ld8_bf16(a, b, pb + (size_t)k * (MTS * D) + e); m[2 * j] = m[2 * j] + a; m[2 * j + 1] = m[2 * j + 1] + b; } }
            else ld8_bf16(m[2 * j], m[2 * j + 1], mm + e); }
    }
}
template <bool HAS_MM, bool OUT_F32, int WANT_RSTD  > __device__ __forceinline__ void row_finish(f32x4 (&v)[4], const f32x4 (&m)[4], const f32x4 (&g)[4], void* xout, float* rstd_out, int lane) {
    if (HAS_MM) {
        float s = 0.f;
#pragma unroll
        for (int j = 0; j < 4; ++j) s += (m[j].x * m[j].x + m[j].y * m[j].y) + (m[j].z * m[j].z + m[j].w * m[j].w);
        const float rs = __builtin_amdgcn_rsqf(wave_sum(s) * (1.f / D) + EPS);
#pragma unroll
        for (int j = 0; j < 4; ++j) v[j] = v[j] + m[j] * rs * g[j];
    }
#pragma unroll
    for (int j = 0; j < 2; ++j) { const int e = 8 * lane + 512 * j;
        if (OUT_F32) { *(f32x4*)((float*)xout + e) = v[2 * j]; *(f32x4*)((float*)xout + e + 4) = v[2 * j + 1]; }
        else { u32x4 w; w.x = pg8::cvt_pk_bf16(v[2 * j].x, v[2 * j].y); w.y = pg8::cvt_pk_bf16(v[2 * j].z, v[2 * j].w); w.z = pg8::cvt_pk_bf16(v[2 * j + 1].x, v[2 * j + 1].y); w.w = pg8::cvt_pk_bf16(v[2 * j + 1].z, v[2 * j + 1].w);
            *(u32x4*)((bf16_t*)xout + e) = w; } }
    if (WANT_RSTD) {
        float s = 0.f;
#pragma unroll
        for (int j = 0; j < 4; ++j) s += (v[j].x * v[j].x + v[j].y * v[j].y) + (v[j].z * v[j].z + v[j].w * v[j].w);
        const float tot = wave_sum(s);
        if (WANT_RSTD == 2) { if (lane < 4) rstd_out[lane] = lane == 0 ? tot : 0.f; }
        else if (lane == 0) rstd_out[0] = __builtin_amdgcn_rsqf(tot * (1.f / D) + EPS);
    }
}
template <bool XIN_F32, bool HAS_MM, bool OUT_F32, bool WANT_RSTD> __device__ __forceinline__ void row_op(const void* xin, const bf16_t* mm, const bf16_t* pb, int ns, const float* g1, void* xout, float* rstd_out, int lane) {
    f32x4 v[4], m[4], g[4];
#pragma unroll
    for (int j = 0; j < 4; ++j) g[j] = HAS_MM ? *(const f32x4*)(g1 + 8 * lane + 512 * (j >> 1) + 4 * (j & 1)) : (f32x4){0.f, 0.f, 0.f, 0.f};
    row_load<XIN_F32, HAS_MM>(v, m, xin, mm, pb, ns, lane);
    row_finish<HAS_MM, OUT_F32, WANT_RSTD>(v, m, g, xout, rstd_out, lane);
}
template <int XSRC, bool OUT_F32, bool WANT_RSTD> __device__ __forceinline__ void rowop_phase(const float* xp, const float* xs, bf16_t* XB, const bf16_t* MMb, const bf16_t* PB, int ns, const float* g1, float* outf, float* RSTD, int gw, int NGW, int lane) {
    f32x4 g[4];
#pragma unroll
    for (int j = 0; j < 4; ++j) g[j] = *(const f32x4*)(g1 + 8 * lane + 512 * (j >> 1) + 4 * (j & 1));
    for (int m0 = gw; m0 < MT; m0 += 2 * NGW) {
        const int m1 = m0 + NGW; const bool has1 = m1 < MT;
        f32x4 v0[4], q0[4], v1[4], q1[4];
        const void* x0 = XSRC == 0 ? (const void*)(m0 < MTP ? xp + (size_t)m0 * D : xs + (size_t)(m0 - MTP) * D) : (const void*)(XB + (size_t)m0 * D);
        row_load<XSRC == 0, true>(v0, q0, x0, MMb + (size_t)m0 * D, m0 >= MTP ? PB + (size_t)(m0 - MTP) * D : nullptr, ns, lane);
        if (has1) { const void* x1 = XSRC == 0 ? (const void*)(m1 < MTP ? xp + (size_t)m1 * D : xs + (size_t)(m1 - MTP) * D) : (const void*)(XB + (size_t)m1 * D);
            row_load<XSRC == 0, true>(v1, q1, x1, MMb + (size_t)m1 * D, m1 >= MTP ? PB + (size_t)(m1 - MTP) * D : nullptr, ns, lane); }
        row_finish<true, OUT_F32, WANT_RSTD>(v0, q0, g, OUT_F32 ? (void*)(outf + (size_t)m0 * D) : (void*)(XB + (size_t)m0 * D), RSTD + m0, lane);
        if (has1) row_finish<true, OUT_F32, WANT_RSTD>(v1, q1, g, OUT_F32 ? (void*)(outf + (size_t)m1 * D) : (void*)(XB + (size_t)m1 * D), RSTD + m1, lane);
    }
}

template <int XSRC, bool OUT_F32, bool WANT_RSTD> __device__ __forceinline__ void sample_rowop_after_gemm(const Ctx& C, const pg8::SchedTail& S, unsigned* cnt, const float* xs, bf16_t* XB, const bf16_t* PB, const float* g1, float* outf, float* RSTD) {
    pg8::Unit u; bool any = false;
    for (int i = 0; S.next(i, u); ++i) any |= (u.kind == 1);
    if (!any) return;
    f32x4 g[4];
#pragma unroll
    for (int j = 0; j < 4; ++j) g[j] = *(const f32x4*)(g1 + 8 * C.lane + 512 * (j >> 1) + 4 * (j & 1));
    for (int i = 0; S.next(i, u); ++i) {
        if (u.kind != 1) continue;
        const unsigned target = 4u * (unsigned)S.NS; const int nrows = 256 / (4 * S.NS), r0 = u.pm * 256 + (u.pn * S.NS + u.ks) * nrows;
        if (C.tid == 0) { unsigned sp = 0;
            while (__hip_atomic_load(cnt + 64 * (u.pm - 64), __ATOMIC_RELAXED, __HIP_MEMORY_SCOPE_AGENT) < target) { __builtin_amdgcn_s_sleep(2); if (++sp > (1u << 22)) break; }
            __builtin_amdgcn_fence(__ATOMIC_ACQUIRE, "agent"); asm volatile("s_waitcnt vmcnt(0)" ::: "memory"); }
        __syncthreads();
        for (int k = C.wave; k < nrows; k += 8) {
            const int m0 = r0 + k; f32x4 v0[4], q0[4];
            const void* x0 = XSRC == 0 ? (const void*)(xs + (size_t)(m0 - MTP) * D) : (const void*)(XB + (size_t)m0 * D);
            row_load<XSRC == 0, true>(v0, q0, x0, nullptr, PB + (size_t)(m0 - MTP) * D, S.NS, C.lane);
            row_finish<true, OUT_F32, WANT_RSTD ? 2 : 0>(v0, q0, g, OUT_F32 ? (void*)(outf + (size_t)m0 * D) : (void*)(XB + (size_t)m0 * D), RSTD + (size_t)m0 * 4, C.lane);
        }
    }
}

template <int STAGE> __device__ __forceinline__ void p0_stage(const Ctx& C, const Args& A, int widx, int nw) {
    LAS float* scr = (LAS float*)(C.lds + C.wave * 16384);
    const int gw = widx * NWAVES + C.wave, NGW = nw * NWAVES;
    unsigned char* ws = C.ws; unsigned char* ob = (unsigned char*)C.out;
    constexpr int I_G1 = 16 * 192, I_G3 = 48 * 32, I_F1 = 16 * 176, I_F2 = 44 * 32, I_R1 = 16 * 64, I_R2 = 16 * 32, I_AX = 8;
    if constexpr (STAGE == 0) {
        for (int it = gw; it < I_G1; it += NGW) p0_transpose_item<0>(A.in[5], 1024, 6144, (bf16_t*)(ob + DO_WG1), 0, scr, it, C.lane, A.in[4] + 0 * D);
        for (int m = gw; m < MT; m += NGW) {
            const float* xr = m < MTP ? A.in[0] + (size_t)m * D : A.in[1] + (size_t)(m - MTP) * D;
            row_op<true, false, false, true>(xr, nullptr, nullptr, 0, nullptr, (bf16_t*)(ob + DO_HN) + (size_t)m * D, (float*)(ws + WS_RSTD) + m, C.lane);
        }
    }
    if constexpr (STAGE == 1) {
        constexpr int NITEMS = I_G3 + I_F1 + I_F2 + I_R1 + 16 * I_AX;
        for (int it = gw; it < NITEMS; it += NGW) {
            int r = it;
            if (r < I_G3) { p0_transpose_item<0>(A.in[11], 3072, 1024, (bf16_t*)(ws + WS_WG3), 0, scr, r, C.lane); continue; } r -= I_G3;
            if (r < I_F1) { p0_transpose_item<1>(A.in[21], 1024, 5632, (bf16_t*)(ws + WS_WF1), 0, scr, r, C.lane, A.in[4] + 2 * D); continue; } r -= I_F1;
            if (r < I_F2) { p0_transpose_item<0>(A.in[22], 2816, 1024, (bf16_t*)(ws + WS_WF2), 0, scr, r, C.lane); continue; } r -= I_F2;
            if (r < I_R1) { p0_transpose_item<0>(A.in[12], 1024, 2048, (bf16_t*)(ws + WS_WR1), 0, scr, r, C.lane, A.in[4] + 4 * D); continue; } r -= I_R1;
            { const int hg = r / I_AX, h = hg >> 1, gate = hg & 1;
              p0_transpose_item<0>((gate ? A.in[17] : A.in[15]) + (size_t)h * 16384, 128, 128, (bf16_t*)(ws + WS_WAX) + (size_t)h * 256 * 128, gate * 128, scr, r % I_AX, C.lane); }
        }
        const int gt = widx * NTHR + C.tid, NGT = nw * NTHR;
        for (int i = gt; i < 8 * 128 * 128; i += NGT) { const int t = (i >> 7) & 127, sx = i & 127; ((bf16_t*)(ws + WS_WSB))[i] = (bf16_t)f2bf(sx <= t ? A.in[9][i] : 0.f); }
        for (int i = gt; i < 1024; i += NGT) { const float l = A.in[19][i]; ((float*)(ws + WS_SP))[i] = (l < 0.f ? -l : 0.f) + log1pf(expf(-fabsf(l))); }
    }
    if constexpr (STAGE == 2) {
        constexpr int NITEMS = I_R2 + I_F1 + I_F2;
        for (int it = gw; it < NITEMS; it += NGW) {
            int r = it;
            if (r < I_R2) { p0_transpose_item<0>(A.in[20], 1024, 1024, (bf16_t*)(ws + WS_WR2), 0, scr, r, C.lane); continue; } r -= I_R2;
            if (r < I_F1) { p0_transpose_item<1>(A.in[21] + (size_t)1024 * 5632, 1024, 5632, (bf16_t*)(ws + WS_WF1B), 0, scr, r, C.lane, A.in[4] + 6 * D); continue; } r -= I_F1;
            p0_transpose_item<0>(A.in[22] + (size_t)2816 * 1024, 2816, 1024, (bf16_t*)(ws + WS_WF2B), 0, scr, r, C.lane);
        }
    }
}
template <int STAGE> __device__ __forceinline__ void p0_in_tail(const Ctx& C, const Args& A, int nunits, int bx) {
    const int nbusy = nunits % C.G;
    if (nbusy == 0) p0_stage<STAGE>(C, A, C.vcu, C.G);
    else if (bx >= nbusy) p0_stage<STAGE>(C, A, bx - nbusy, C.G - nbusy);
}

__device__ __forceinline__ void spatial_stats(const Ctx& C, int tok0, LAS float* RS, LAS float* MUR) {
    if (C.tid < 128) { const f32x2* ST = (const f32x2*)(C.ws + WS_ST); float s = 0.f, q = 0.f;
#pragma unroll 8
        for (int p = 0; p < 24; ++p) { const f32x2 v = ST[(size_t)p * MT + tok0 + C.tid]; s += v.x; q += v.y; }
        const float mean = s * (1.f / DG), var = q * (1.f / DG) - mean * mean, rstd = __builtin_amdgcn_rsqf(var + EPS);
        RS[C.tid] = rstd; MUR[C.tid] = mean * rstd; }
}
template <bool DRY> __device__ __forceinline__ void spatial_phase(const Ctx& C, const Args& A) {
    LAS unsigned char* lds = C.lds;
    LAS float* RS = (LAS float*)(lds + 34816); LAS float* MUR = (LAS float*)(lds + 36864);
    const int fr = C.lane & 15, fq = C.lane >> 4;
    bf16_t* U = (bf16_t*)(C.ws + WS_U); const bf16_t* VT = (const bf16_t*)(C.ws + WS_V); const bf16_t* WSB = (const bf16_t*)(C.ws + WS_WSB);
    const float* ln_g = A.in[7]; const float* ln_b = A.in[8]; const float* b_s = A.in[10]; const float* w_s = A.in[9];
    const f32x2* ST = (const f32x2*)(C.ws + WS_ST);
    for (int base = C.vcu; base < 1024; base += 4 * C.G) {
        const int g = base & 7;
        __syncthreads();
        { const int i = C.tid >> 7, t = C.tid & 127, id = base + C.G * i;
          if (id < 1024) { const int tok = (id >> 3) * 128 + t; float sm = 0.f, q = 0.f;
#pragma unroll 8
            for (int p = 0; p < 24; ++p) { const f32x2 v = ST[(size_t)p * MT + tok]; sm += v.x; q += v.y; }
            const float mean = sm * (1.f / DG), var = q * (1.f / DG) - mean * mean, rstd = __builtin_amdgcn_rsqf(var + EPS);
            RS[C.tid] = rstd; MUR[C.tid] = mean * rstd; } }
#pragma unroll
        for (int i = 0; i < 4; ++i) { const int p = C.tid + 512 * i, row = p >> 4, c16 = p & 15;
            const u32x4 w = *(const u32x4*)(WSB + (size_t)g * 16384 + row * 128 + c16 * 8); *(LAS u32x4*)(lds + row * 272 + c16 * 16) = w; }
        __syncthreads();
        float bsv[8];
#pragma unroll
        for (int m = 0; m < 8; ++m) bsv[m] = b_s[g * 128 + 16 * m + fr];
        u32x4 rB[3][4]; u32x2 rU[3][8]; float rG[3], rBn[3];
#define SP_ISSUE(s_) do { const int i_ = (s_) / 3, j_ = (s_) % 3, sl_ = (s_) % 3, id_ = base + C.G * i_; if (id_ < 1024) { const int tok0_ = (id_ >> 3) * 128, chb_ = g * 384 + 48 * C.wave + 16 * j_; \
            rG[sl_] = ln_g[chb_ + fr]; rBn[sl_] = ln_b[chb_ + fr]; \
            _Pragma("unroll") for (int kk = 0; kk < 4; ++kk) rB[sl_][kk] = *(const u32x4*)(VT + (size_t)(chb_ + fr) * MT + tok0_ + 32 * kk + 8 * fq); \
            _Pragma("unroll") for (int m = 0; m < 8; ++m) rU[sl_][m] = *(const u32x2*)(U + (size_t)(tok0_ + 16 * m + fr) * DG + chb_ + 4 * fq); } } while (0)
        SP_ISSUE(0); SP_ISSUE(1);
#pragma unroll
        for (int s = 0; s < 12; ++s) {
            if (s + 2 < 12) SP_ISSUE(s + 2);
            const int i = s / 3, j = s % 3, sl = s % 3, id = base + C.G * i;
            if (id < 1024) {
                const int tok0 = (id >> 3) * 128, chb = g * 384 + 48 * C.wave + 16 * j;
                const float Gc = rG[sl], Bc = rBn[sl];
                bf16x8 bfrag[4];
#pragma unroll
                for (int kk = 0; kk < 4; ++kk) {
                    const u32x4 raw = rB[sl][kk];
                    const LAS float* rp = RS + i * 128 + 32 * kk + 8 * fq; const LAS float* mp = MUR + i * 128 + 32 * kk + 8 * fq;
                    const f32x4 r0 = *(const LAS f32x4*)rp, r1 = *(const LAS f32x4*)(rp + 4), m0 = *(const LAS f32x4*)mp, m1 = *(const LAS f32x4*)(mp + 4);
                    const f32x4 vlo = (f32x4){bflo(raw.x), bfhi(raw.x), bflo(raw.y), bfhi(raw.y)}, vhi = (f32x4){bflo(raw.z), bfhi(raw.z), bflo(raw.w), bfhi(raw.w)};
                    const f32x4 o0 = vlo * (r0 * Gc) + (Bc - m0 * Gc), o1 = vhi * (r1 * Gc) + (Bc - m1 * Gc);
                    u32x4 w; w.x = pg8::cvt_pk_bf16(o0.x, o0.y); w.y = pg8::cvt_pk_bf16(o0.z, o0.w); w.z = pg8::cvt_pk_bf16(o1.x, o1.y); w.w = pg8::cvt_pk_bf16(o1.z, o1.w);
                    bfrag[kk] = __builtin_bit_cast(bf16x8, w);
                }
#pragma unroll
                for (int m = 0; m < 8; ++m) { f32x4 acc = (f32x4){0.f, 0.f, 0.f, 0.f};
#pragma unroll
                    for (int kk = 0; kk < 4; ++kk) if (kk <= (m >> 1)) {
                        const bf16x8 af = *(const LAS bf16x8*)(lds + (16 * m + fr) * 272 + (32 * kk + 8 * fq) * 2);
                        acc = __builtin_amdgcn_mfma_f32_16x16x32_bf16(bfrag[kk], af, acc, 0, 0, 0); }
                    const float bs = bsv[m]; const u32x2 uw = rU[sl][m];
                    u32x2 o; o.x = pg8::cvt_pk_bf16(bflo(uw.x) * (acc[0] + bs), bfhi(uw.x) * (acc[1] + bs)); o.y = pg8::cvt_pk_bf16(bflo(uw.y) * (acc[2] + bs), bfhi(uw.y) * (acc[3] + bs));
                    *(u32x2*)(U + (size_t)(tok0 + 16 * m + fr) * DG + chb + 4 * fq) = o; }
            }
        }
#undef SP_ISSUE
    }
    for (int r = C.vcu; r < 256; r += C.G) {
        const int sc = r >> 5, g = (r >> 2) & 7, quarter = r & 3, tok0 = MTP + sc * 128;
        __syncthreads();
        if (C.tid < 128) { float sm = 0.f, q = 0.f;
#pragma unroll 8
            for (int p = 0; p < 24; ++p) { const f32x2 v = ST[(size_t)p * MT + tok0 + C.tid]; sm += v.x; q += v.y; }
            const float mean = sm * (1.f / DG), var = q * (1.f / DG) - mean * mean, rstd = __builtin_amdgcn_rsqf(var + EPS);
            RS[C.tid] = rstd; MUR[C.tid] = mean * rstd; }
        __syncthreads();
        float* OV = C.out + O_SV;
#pragma unroll
        for (int p4 = 0; p4 < 3; ++p4) { const int p = C.tid + NTHR * p4;
            const int dbl = p / 96, cl = p - dbl * 96, ch = g * 384 + quarter * 96 + cl, db = sc * 16 + dbl;
            const float Gc = ln_g[ch], Bc = ln_b[ch];
            const u32x4 raw = *(const u32x4*)(VT + (size_t)ch * MT + MTP + db * 8);
            float vn[8]; const float vv[8] = {bflo(raw.x), bfhi(raw.x), bflo(raw.y), bfhi(raw.y), bflo(raw.z), bfhi(raw.z), bflo(raw.w), bfhi(raw.w)};
#pragma unroll
            for (int sx = 0; sx < 8; ++sx) { vn[sx] = vv[sx] * (RS[dbl * 8 + sx] * Gc) + (Bc - MUR[dbl * 8 + sx] * Gc); OV[(size_t)(db * 8 + sx) * DG + ch] = vn[sx]; }
#pragma unroll
            for (int t = 0; t < 8; ++t) { float mx = b_s[g * 128 + t];
#pragma unroll
                for (int sx = 0; sx <= t; ++sx) mx += w_s[g * 16384 + t * 128 + sx] * vn[sx];
                bf16_t* up = U + (size_t)(MTP + db * 8 + t) * DG + ch; *up = (bf16_t)f2bf(bflo((unsigned)*up) * mx); }
        }
    }
    __syncthreads();
}

constexpr int RG_TILE = 64, RG_NT = MT / RG_TILE  , RG_NTP = MTP / RG_TILE  , RG_PITCH = 132;
__device__ __forceinline__ float one_minus_exp(float x, float ex  ) {
    float p = x * (1.f / 5040.f) + (1.f / 720.f); p = p * x + (1.f / 120.f); p = p * x + (1.f / 24.f); p = p * x + (1.f / 6.f); p = p * x + 0.5f; p = p * x + 1.0f; p = -(p * x);
    const float e = 1.0f - ex;
    return x > -0.3f ? p : e;
}
__device__ __forceinline__ void rg_phase1(const Ctx& C, const Args& A) {
    LAS unsigned char* lds = C.lds;
    LAS float* XC = (LAS float*)(lds + 69632); LAS float* BB = XC; LAS float* AA = (LAS float*)(lds + 103424); LAS f32x2* SUM = (LAS f32x2*)(lds + 137216);
    const int fr = C.lane & 15, fq = C.lane >> 4, h = C.vcu & 7;
    const bf16_t* XBR = (const bf16_t*)(C.ws + WS_U) + (size_t)MT * D; const bf16_t* WAX = (const bf16_t*)(C.ws + WS_WAX); const float* SP = (const float*)(C.ws + WS_SP);
    bf16_t* GATE = (bf16_t*)(C.ws + WS_U); f32x2* TS = (f32x2*)(C.ws + WS_TS); unsigned* FLG = (unsigned*)(C.ws + WS_FLG); LAS float* CARRY = (LAS float*)(lds + 137216 + 4096);
    const float* conv_w = A.in[13]; const float* conv_b = A.in[14]; const float* b_a = A.in[16]; const float* b_x = A.in[18]; const float* st_conv = A.in[2]; const float* st_h = A.in[3];
#pragma unroll
    for (int i = 0; i < 8; ++i) { const int p = C.tid + 512 * i, row = p >> 4, c16 = p & 15; *(LAS u32x4*)(lds + row * 272 + c16 * 16) = *(const u32x4*)(WAX + ((size_t)h * 256 + row) * 128 + c16 * 8); }
    const int cg8 = C.tid & 15, tr = C.tid >> 4, c8 = h * 128 + cg8 * 8;
    f32x4 w[4][2], bb[2];
#pragma unroll
    for (int k = 0; k < 4; ++k) { w[k][0] = *(const f32x4*)(conv_w + k * 1024 + c8); w[k][1] = *(const f32x4*)(conv_w + k * 1024 + c8 + 4); }
    bb[0] = *(const f32x4*)(conv_b + c8); bb[1] = *(const f32x4*)(conv_b + c8 + 4);
    const int mb = C.wave & 3, nh = C.wave >> 2;
    LAS float* HC = (LAS float*)(lds + 141824);
    if (C.tid < 128) { HC[C.tid] = b_a[h * 128 + C.tid]; HC[128 + C.tid] = b_x[h * 128 + C.tid]; HC[256 + C.tid] = SP[h * 128 + C.tid]; }
    u32x4 pre[2][4];
#define RG_LOADROWS(tile_) do { const int tok0_ = (tile_) * RG_TILE; const bool smp_ = (tile_) >= RG_NTP; \
        _Pragma("unroll") for (int i = 0; i < 2; ++i) { const int tok_ = tok0_ + tr + 32 * i, tl_ = smp_ ? ((tok_ - MTP) & 7) : (tok_ & (SEQ - 1)); \
            _Pragma("unroll") for (int k = 0; k < 4; ++k) { pre[i][k] = (u32x4){0u, 0u, 0u, 0u}; if (tl_ + k - 3 >= 0) pre[i][k] = *(const u32x4*)(XBR + (size_t)(tok_ + k - 3) * D + c8); } } } while (0)
    if (C.vcu < RG_NT * 8) RG_LOADROWS(C.vcu >> 3);
    __syncthreads();
    for (int id = C.vcu; id < RG_NT * 8; id += C.G) {
        const int tile = id >> 3, tok0 = tile * RG_TILE; const bool sample = tile >= RG_NTP;
        {
#pragma unroll
            for (int i = 0; i < 2; ++i) { const int t = tr + 32 * i, tok = tok0 + t;
                const int L = sample ? 8 : SEQ, tl = sample ? ((tok - MTP) & 7) : (tok & (SEQ - 1)), sq = sample ? ((tok - MTP) >> 3) : (tok >> 11);
                f32x4 x0 = bb[0], x1 = bb[1];
#pragma unroll
                for (int k = 0; k < 4; ++k) { const u32x4 raw = pre[i][k];
                    f32x4 r0 = (f32x4){bflo(raw.x), bfhi(raw.x), bflo(raw.y), bfhi(raw.y)}, r1 = (f32x4){bflo(raw.z), bfhi(raw.z), bflo(raw.w), bfhi(raw.w)};
                    if (sample && tl + k - 3 < 0) { const float* hp = st_conv + (size_t)(sq * 3 + (tl + k)) * D + c8; r0 = *(const f32x4*)hp; r1 = *(const f32x4*)(hp + 4); }
                    x0 = x0 + w[k][0] * r0; x1 = x1 + w[k][1] * r1;
                    if (k == 3 && tl >= L - 3) { float* op = C.out + (sample ? O_SCONV : O_PCONV) + (size_t)(sq * 3 + (tl - (L - 3))) * D + c8; *(f32x4*)op = r0; *(f32x4*)(op + 4) = r1; } }
                *(LAS f32x4*)(XC + t * RG_PITCH + cg8 * 8) = x0; *(LAS f32x4*)(XC + t * RG_PITCH + cg8 * 8 + 4) = x1; }
        }
        __syncthreads();
        bf16x8 af[4]; f32x4 xc4[4];
        {
#pragma unroll
            for (int kk = 0; kk < 4; ++kk) { const LAS float* xp = XC + (16 * mb + fr) * RG_PITCH + 32 * kk + 8 * fq; const f32x4 a0 = *(const LAS f32x4*)xp, a1 = *(const LAS f32x4*)(xp + 4);
                u32x4 wv; wv.x = pg8::cvt_pk_bf16(a0.x, a0.y); wv.y = pg8::cvt_pk_bf16(a0.z, a0.w); wv.z = pg8::cvt_pk_bf16(a1.x, a1.y); wv.w = pg8::cvt_pk_bf16(a1.z, a1.w); af[kk] = __builtin_bit_cast(bf16x8, wv); }
#pragma unroll
            for (int nb = 0; nb < 4; ++nb) xc4[nb] = *(const LAS f32x4*)(XC + (16 * mb + fr) * RG_PITCH + 64 * nh + 16 * nb + 4 * fq);
        }
        __syncthreads();
        if (id + C.G < RG_NT * 8) RG_LOADROWS((id + C.G) >> 3);
        u32x4 gpre[2];
#pragma unroll
        for (int i = 0; i < 2; ++i) { const int p = C.tid + 512 * i; gpre[i] = *(const u32x4*)(GATE + (size_t)(tok0 + (p >> 4)) * D + h * 128 + (p & 15) * 8); }
        {
#pragma unroll
            for (int nb = 0; nb < 4; ++nb) {
                f32x4 ra = (f32x4){0.f, 0.f, 0.f, 0.f}, ia = ra;
                const LAS unsigned char* wp = lds + (64 * nh + 16 * nb + fr) * 272 + 16 * fq;
#pragma unroll
                for (int kk = 0; kk < 4; ++kk) { const bf16x8 ba = *(const LAS bf16x8*)(wp + 64 * kk), bx = *(const LAS bf16x8*)(wp + 128 * 272 + 64 * kk);
                    ra = __builtin_amdgcn_mfma_f32_16x16x32_bf16(ba, af[kk], ra, 0, 0, 0); ia = __builtin_amdgcn_mfma_f32_16x16x32_bf16(bx, af[kk], ia, 0, 0, 0); }
                const int t = 16 * mb + fr, cl = 64 * nh + 16 * nb + 4 * fq;
                f32x4 av, bv; const f32x4 bav = *(const LAS f32x4*)(HC + cl), bxv = *(const LAS f32x4*)(HC + 128 + cl), spv = *(const LAS f32x4*)(HC + 256 + cl);
#pragma unroll
                for (int j = 0; j < 4; j += 2) {
                    const f32x2 zr = ((f32x2){ra[j], ra[j + 1]} + (f32x2){bav[j], bav[j + 1]}) * -1.4426950409f, zi = ((f32x2){ia[j], ia[j + 1]} + (f32x2){bxv[j], bxv[j + 1]}) * -1.4426950409f;
                    f32x2 er, ei; er.x = __builtin_amdgcn_exp2f(zr.x); er.y = __builtin_amdgcn_exp2f(zr.y); ei.x = __builtin_amdgcn_exp2f(zi.x); ei.y = __builtin_amdgcn_exp2f(zi.y);
                    const f32x2 dr = er + 1.0f, di = ei + 1.0f; f32x2 r, ii; r.x = __builtin_amdgcn_rcpf(dr.x); r.y = __builtin_amdgcn_rcpf(dr.y); ii.x = __builtin_amdgcn_rcpf(di.x); ii.y = __builtin_amdgcn_rcpf(di.y);
                    const f32x2 la = r * (f32x2){spv[j], spv[j + 1]} * -8.0f, le = la * 1.4426950409f; f32x2 a; a.x = __builtin_amdgcn_exp2f(le.x); a.y = __builtin_amdgcn_exp2f(le.y);
                    const f32x2 x2 = la * 2.0f;
                    f32x2 p = x2 * (1.f / 5040.f) + (1.f / 720.f); p = p * x2 + (1.f / 120.f); p = p * x2 + (1.f / 24.f); p = p * x2 + (1.f / 6.f); p = p * x2 + 0.5f; p = p * x2 + 1.0f; p = -(p * x2);
                    const f32x2 e = 1.0f - a * a; f32x2 om; om.x = x2.x > -0.3f ? p.x : e.x; om.y = x2.y > -0.3f ? p.y : e.y;
                    f32x2 sq; sq.x = __builtin_amdgcn_sqrtf(om.x); sq.y = __builtin_amdgcn_sqrtf(om.y);
                    const f32x2 b2 = sq * (ii * (f32x2){xc4[nb][j], xc4[nb][j + 1]});
                    av[j] = a.x; av[j + 1] = a.y; bv[j] = b2.x; bv[j + 1] = b2.y; }
                *(LAS f32x4*)(AA + t * RG_PITCH + cl) = av; *(LAS f32x4*)(BB + t * RG_PITCH + cl) = bv;
            }
        }
        __syncthreads();
        {
            const int chl = C.tid & 127, q = C.tid >> 7, ch = h * 128 + chl;
            if (!sample) {
                float Ap = 1.f, Bp = 0.f;
#pragma unroll 4
                for (int t = 16 * q; t < 16 * q + 16; ++t) { const float a = AA[t * RG_PITCH + chl], b = BB[t * RG_PITCH + chl]; Bp = a * Bp + b; Ap *= a; }
                SUM[q * 128 + chl] = (f32x2){Ap, Bp};
                __syncthreads();
                const int first = tile & ~31, nprev = tile & 31;
                if (C.tid < 128) { float At = 1.f, Bt = 0.f;
#pragma unroll
                    for (int qq = 0; qq < 4; ++qq) { const f32x2 sm = SUM[qq * 128 + chl]; Bt = sm.x * Bt + sm.y; At *= sm.x; }
                    __hip_atomic_store((unsigned long long*)(TS + (size_t)tile * D + ch), ((unsigned long long)__float_as_uint(Bt) << 32) | __float_as_uint(At), __ATOMIC_RELAXED, __HIP_MEMORY_SCOPE_AGENT); }
                asm volatile("s_waitcnt vmcnt(0)" ::: "memory");
                __syncthreads();
                if (C.tid == 0) __hip_atomic_store(FLG + (size_t)(tile * 8 + h) * 16, 1u, __ATOMIC_RELAXED, __HIP_MEMORY_SCOPE_AGENT);
                if (C.wave == 0) { unsigned sp = 0;
                    for (;;) { const unsigned f = C.lane < nprev ? __hip_atomic_load(FLG + (size_t)((first + C.lane) * 8 + h) * 16, __ATOMIC_RELAXED, __HIP_MEMORY_SCOPE_AGENT) : 1u;
                        if (__builtin_amdgcn_ballot_w64(f == 0u) == 0ull) break; __builtin_amdgcn_s_sleep(2); if (++sp > (1u << 22)) break; }
                    __builtin_amdgcn_fence(__ATOMIC_ACQUIRE, "agent"); }
                asm volatile("s_waitcnt vmcnt(0)" ::: "memory");
                __syncthreads();
                if (C.tid < 128) { float carry = 0.f;
#pragma unroll
                    for (int j0 = 0; j0 < 32; j0 += 16) { unsigned long long sv[16];
#pragma unroll
                        for (int j = 0; j < 16; ++j) sv[j] = (j0 + j < nprev) ? __hip_atomic_load((const unsigned long long*)(TS + (size_t)(first + j0 + j) * D + ch), __ATOMIC_RELAXED, __HIP_MEMORY_SCOPE_AGENT) : 0x000000003f800000ull;
#pragma unroll
                        for (int j = 0; j < 16; ++j) carry = __uint_as_float((unsigned)sv[j]) * carry + __uint_as_float((unsigned)(sv[j] >> 32)); }
                    CARRY[chl] = carry; }
                __syncthreads();
                float hv = CARRY[chl];
                for (int qq = 0; qq < q; ++qq) { const f32x2 sm = SUM[qq * 128 + chl]; hv = sm.x * hv + sm.y; }
#pragma unroll 4
                for (int t = 16 * q; t < 16 * q + 16; ++t) { hv = AA[t * RG_PITCH + chl] * hv + BB[t * RG_PITCH + chl]; AA[t * RG_PITCH + chl] = hv; }
                if (q == 3 && nprev == 31) C.out[O_PH + (size_t)(tile >> 5) * D + ch] = hv;
            } else {
#pragma unroll
                for (int s2 = 0; s2 < 2; ++s2) { const int db = ((tok0 - MTP) >> 3) + 2 * q + s2; float hv = st_h[(size_t)db * D + ch];
#pragma unroll
                    for (int t8 = 0; t8 < 8; ++t8) { const int t = 16 * q + 8 * s2 + t8; hv = AA[t * RG_PITCH + chl] * hv + BB[t * RG_PITCH + chl]; AA[t * RG_PITCH + chl] = hv; }
                    C.out[O_SH + (size_t)db * D + ch] = hv; }
            }
        }
        __syncthreads();
#pragma unroll
        for (int i = 0; i < 2; ++i) { const int p = C.tid + 512 * i, t = p >> 4, c8l = (p & 15) * 8;
            const f32x4 h0 = *(const LAS f32x4*)(AA + t * RG_PITCH + c8l), h1 = *(const LAS f32x4*)(AA + t * RG_PITCH + c8l + 4); const u32x4 gt = gpre[i];
            u32x4 o; o.x = pg8::cvt_pk_bf16(h0.x * bflo(gt.x), h0.y * bfhi(gt.x)); o.y = pg8::cvt_pk_bf16(h0.z * bflo(gt.y), h0.w * bfhi(gt.y)); o.z = pg8::cvt_pk_bf16(h1.x * bflo(gt.z), h1.y * bfhi(gt.z)); o.w = pg8::cvt_pk_bf16(h1.z * bflo(gt.w), h1.w * bfhi(gt.w));
            *(u32x4*)(GATE + (size_t)(tok0 + t) * D + h * 128 + c8l) = o; }
        __syncthreads();
    }
#undef RG_LOADROWS
}
template <bool DRY> __device__ __forceinline__ void rg_phase2(const Ctx& C) {
    LAS float* CARRY = (LAS float*)C.lds;
    bf16_t* GATE = (bf16_t*)(C.ws + WS_U); const bf16_t* HL = (const bf16_t*)(C.ws + WS_V); const bf16_t* CA = (const bf16_t*)(C.ws + WS_V + (size_t)MT * D * 4); const f32x2* TS = (const f32x2*)(C.ws + WS_TS);
    for (int id = C.vcu; id < RG_NT * 8; id += C.G) {
        const int tile = id >> 3, h = id & 7, tok0 = tile * RG_TILE; const bool sample = tile >= RG_NTP;
        if (C.tid < 128) { const int ch = h * 128 + C.tid; float carry = 0.f;
            if (!sample) { const int first = tile & ~31, nprev = tile & 31;
                f32x2 sv[31];
#pragma unroll
                for (int j = 0; j < 31; ++j) sv[j] = (j < nprev) ? TS[(size_t)(first + j) * D + ch] : (f32x2){1.f, 0.f};
#pragma unroll
                for (int j = 0; j < 31; ++j) carry = sv[j].x * carry + sv[j].y; }
            CARRY[C.tid] = carry; }
        __syncthreads();
#pragma unroll
        for (int i = 0; i < 2; ++i) { const int p = C.tid + 512 * i, t = p >> 4, cg8 = p & 15, tok = tok0 + t, c8 = h * 128 + cg8 * 8; const size_t off = (size_t)tok * D + c8;
            const u32x4 hlw = *(const u32x4*)(HL + off); const f32x4 h0 = (f32x4){bflo(hlw.x), bfhi(hlw.x), bflo(hlw.y), bfhi(hlw.y)}, h1 = (f32x4){bflo(hlw.z), bfhi(hlw.z), bflo(hlw.w), bfhi(hlw.w)}; const u32x4 ca = *(const u32x4*)(CA + off), gt = *(const u32x4*)(GATE + off);
            const f32x4 c0 = *(const LAS f32x4*)(CARRY + cg8 * 8), c1 = *(const LAS f32x4*)(CARRY + cg8 * 8 + 4);
            f32x4 v0 = h0, v1 = h1;
            if (!sample) { v0 = v0 + (f32x4){bflo(ca.x), bfhi(ca.x), bflo(ca.y), bfhi(ca.y)} * c0; v1 = v1 + (f32x4){bflo(ca.z), bfhi(ca.z), bflo(ca.w), bfhi(ca.w)} * c1; }
            u32x4 o; o.x = pk2(v0.x * bflo(gt.x), v0.y * bfhi(gt.x)); o.y = pk2(v0.z * bflo(gt.y), v0.w * bfhi(gt.y)); o.z = pk2(v1.x * bflo(gt.z), v1.y * bfhi(gt.z)); o.w = pk2(v1.z * bflo(gt.w), v1.w * bfhi(gt.w));
            *(u32x4*)((DRY ? GATE + (size_t)2 * MT * D : GATE) + off) = o;
            if (!sample && (tok & (SEQ - 1)) == SEQ - 1) { float* op = C.out + O_PH + (size_t)(tok >> 11) * D + c8; *(f32x4*)op = v0; *(f32x4*)(op + 4) = v1; } }
        __syncthreads();
    }
}

template <int K, bool DRY = false> __device__ __forceinline__ void run_phase(const Ctx& C, const Args& args) {
    unsigned char* ws = args.ws; unsigned char* ob = (unsigned char*)args.out;
    bf16_t* const Ubuf = (bf16_t*)(ws + WS_U); bf16_t* const Vbuf = (bf16_t*)(ws + WS_V);
    bf16_t* const MMb = Vbuf;
    bf16_t* const HNb = Vbuf + (size_t)MT * D;
    bf16_t* const PB = (bf16_t*)(ws + WS_V + 68 * MiB);
    constexpr int NS_G3 = 8, NS_F2 = 8, NS_G9 = 4;
    const int gw = C.vcu * NWAVES + C.wave, NGW = C.G * NWAVES;
    const float* gains = args.in[4]; float* const RSTD = (float*)(ws + WS_RSTD);
    unsigned* const ECNT = (unsigned*)(ws + WS_CNT); unsigned* const SCNT = ECNT + 4 * 2 * 64 * 64;
    float* const XS1 = (float*)(ws + WS_ST); float* const RS16 = (float*)(ws + WS_ST + 2560 * 1024);
    const int bx = (int)blockIdx.x;

    if constexpr (K == 0) { p0_stage<0>(C, args, C.vcu, C.G); }
    if constexpr (K == 1) {
        const bf16_t* hn0 = (const bf16_t*)(ob + DO_HN); const bf16_t* wg1 = (const bf16_t*)(ob + DO_WG1);
        pg8::Sched S; S.init(hn0, wg1, MT, DG, wg1 + (size_t)DG * D, hn0, DG, MT, D, C.G, bx);
        pg8::EpiG1 E{Ubuf, Vbuf, args.in[6], (f32x2*)(ws + WS_ST), RSTD};
        pg8::gemm_phase(C.lds, D, S, E);
        if (!DRY) p0_in_tail<1>(C, args, 68 * 24, bx);
    }
    if constexpr (K == 2) { spatial_phase<DRY>(C, args); }
    if constexpr (K == 3) {
        pg8::SchedTail S; S.init(Ubuf, ws + WS_WG3, DG, NS_G3, C.G, bx);
        pg8::RmsExchange e1{XS1, ECNT + (0 * 2 + 0) * 4096};
        pg8::EpiTailFused<false> E{PB, SCNT + 0 * 256, e1, (const bf16_t*)(ob + DO_HN), HNb, gains + 1 * D, nullptr, RS16, C.lds + 131072};   pg8::gemm_phase(C.lds, DG, S, E);
        sample_rowop_after_gemm<0, false, true>(C, S, SCNT + 0 * 256, args.in[1], HNb, PB, gains + 1 * D, nullptr, RS16);
    }
    if constexpr (K == 4) {
    }
    if constexpr (K == 5) {
        pg8::Sched S; S.init(HNb, ws + WS_WF1, MT, 2 * DFF, nullptr, nullptr, 0, 0, D, C.G, bx);
        pg8::EpiSwiglu E{Ubuf, RS16}; pg8::gemm_phase(C.lds, D, S, E);
    }
    if constexpr (K == 6) {
        pg8::SchedTail S; S.init(Ubuf, ws + WS_WF2, DFF, NS_F2, C.G, bx);
        pg8::RmsExchange e1{XS1, ECNT + (1 * 2 + 0) * 4096};
        pg8::EpiTailFused<false> E{PB, SCNT + 1 * 256, e1, HNb, HNb, gains + 3 * D, nullptr, RS16, C.lds + 131072}; pg8::gemm_phase(C.lds, DFF, S, E);
        sample_rowop_after_gemm<1, false, true>(C, S, SCNT + 1 * 256, nullptr, HNb, PB, gains + 3 * D, nullptr, RS16);
    }
    if constexpr (K == 7) {
    }
    if constexpr (K == 8) {
        pg8::Sched S; S.init(HNb, ws + WS_WR1, MT, 2 * D, nullptr, nullptr, 0, 0, D, C.G, bx);
        pg8::EpiG6 E{Ubuf, Ubuf + (size_t)MT * D, RS16}; pg8::gemm_phase(C.lds, D, S, E);
        if (!DRY) p0_in_tail<2>(C, args, 68 * 8, bx);
    }
    if constexpr (K == 9) { rg_phase1(C, args); }
    if constexpr (K == 11) {
        pg8::SchedTail S; S.init(Ubuf, ws + WS_WR2, D, NS_G9, C.G, bx);
        pg8::RmsExchange e1{XS1, ECNT + (2 * 2 + 0) * 4096};
        pg8::EpiTailFused<false> E{PB, SCNT + 2 * 256, e1, HNb, HNb, gains + 5 * D, nullptr, RS16, C.lds + 131072}; pg8::gemm_phase(C.lds, D, S, E);
        sample_rowop_after_gemm<1, false, true>(C, S, SCNT + 2 * 256, nullptr, HNb, PB, gains + 5 * D, nullptr, RS16);
    }
    if constexpr (K == 12) {
    }
    if constexpr (K == 13) {
        pg8::Sched S; S.init(HNb, ws + WS_WF1B, MT, 2 * DFF, nullptr, nullptr, 0, 0, D, C.G, bx);
        pg8::EpiSwiglu E{Ubuf, RS16}; pg8::gemm_phase(C.lds, D, S, E);
    }
    if constexpr (K == 14) {
        pg8::SchedTail S; S.init(Ubuf, ws + WS_WF2B, DFF, NS_F2, C.G, bx);
        pg8::RmsExchange e1{XS1, ECNT + (3 * 2 + 0) * 4096};
        pg8::EpiTailFused<true> E{PB, SCNT + 3 * 256, e1, HNb, HNb, gains + 7 * D, args.out, RS16, C.lds + 131072}; pg8::gemm_phase(C.lds, DFF, S, E);
        sample_rowop_after_gemm<1, true, false>(C, S, SCNT + 3 * 256, nullptr, HNb, PB, gains + 7 * D, args.out, RS16);
    }
    if constexpr (K == 15) {
    }
}
constexpr int NPH = 16;
__global__ void __launch_bounds__(NTHR, 2) fwd_kernel(Args args) {
    extern __shared__ __attribute__((aligned(16))) unsigned char lds_raw[];
    Ctx C; C.lds = (LAS unsigned char*)lds_raw; C.tid = threadIdx.x; C.lane = C.tid & 63; C.wave = __builtin_amdgcn_readfirstlane(C.tid >> 6);
    C.G = gridDim.x; { const int bx = blockIdx.x; C.vcu = (C.G % 8 == 0) ? (bx % 8) * (C.G / 8) + bx / 8 : bx; }
    C.out = args.out; C.ws = args.ws;
    for (int u = C.tid; u < 64; u += NTHR) ((LAS unsigned*)(C.lds + LDS_BYTES - 256))[u] = 0u;
    __syncthreads();
    const XcdBarrier bar = xcd_barrier_post((unsigned*)(args.ws + WS_BAR), (volatile LAS unsigned*)(C.lds + LDS_BYTES - 256 + 32));
    const int lo = args.ph_lo, hi = args.ph_hi;
#ifndef REP_MASK
#define REP_MASK 0
#endif
#ifndef XSYNC
#define XSYNC 0
#endif
#define REPS(k) (((REP_MASK >> (k)) & 1) ? 2 : 1)
#ifndef PH_MASK
#define PH_MASK 0xffff
#endif
#define IN(k) (((PH_MASK >> (k)) & 1) && lo <= (k) && (k) < hi)
#if MK_ONE_LAUNCH
#define SEAM(k) do { if ((k) != 3 && (k) != 6 && (k) != 9 && (k) != 11 && (k) != 14 && IN(k) && IN((k) + 1)) { xcd_barrier(bar); } } while (0)
#else
#define SEAM(k) do { } while (0)
#endif
    if (hi == 0x7fffffff) cg::this_grid().sync();
#define PHASE(k) do { if (IN(k)) { if (REPS(k) == 2) run_phase<k, true>(C, args); run_phase<k>(C, args); } SEAM(k); } while (0)
    PHASE(0);
    for (int xs_ = 0; xs_ < XSYNC; ++xs_) cg::this_grid().sync();
    PHASE(1); PHASE(2); PHASE(3); PHASE(4); PHASE(5); PHASE(6); PHASE(7); PHASE(8); PHASE(9); PHASE(10); PHASE(11); PHASE(12); PHASE(13); PHASE(14); PHASE(15);
#undef PHASE
#undef IN
#undef SEAM
}

extern "C" void kernel_launch(void* const* d_in, const int* in_sizes, int n_in, void* d_out, int out_size, void* d_ws, size_t ws_size, hipStream_t stream) {
    static int grid = 0;
    if (grid == 0) {
        int dev = 0, cus = 0, per_cu = 0;
        hipGetDevice(&dev); hipDeviceGetAttribute(&cus, hipDeviceAttributeMultiprocessorCount, dev);
        hipFuncSetAttribute((const void*)fwd_kernel, hipFuncAttributeMaxDynamicSharedMemorySize, LDS_BYTES);
        hipOccupancyMaxActiveBlocksPerMultiprocessor(&per_cu, (const void*)fwd_kernel, NTHR, LDS_BYTES);
        if (per_cu < 1) { fprintf(stderr, "kernel_launch: occupancy query says %d blocks/CU\n", per_cu); per_cu = 1; }
        (void)hipGetLastError();
        grid = cus * per_cu;
        if (n_in != 23 || ws_size < 256 * MiB) fprintf(stderr, "kernel_launch: unexpected n_in %d / ws %zu\n", n_in, ws_size);
    }
    (void)hipMemsetAsync((char*)d_ws + WS_BAR, 0, CTL_ZERO_BYTES, stream);
    Args a{};
    for (int i = 0; i < 23; ++i) a.in[i] = (const float*)d_in[i];
    a.out = (float*)d_out; a.ws = (unsigned char*)d_ws;
#if MK_ONE_LAUNCH
    a.ph_lo = 0; a.ph_hi = NPH;
    void* kargs[] = {&a};
    hipError_t e = hipLaunchCooperativeKernel((const void*)fwd_kernel, dim3(grid), dim3(NTHR), kargs, LDS_BYTES, stream);
    if (e != hipSuccess) fprintf(stderr, "cooperative launch failed: %s (grid %d)\n", hipGetErrorString(e), grid);
#else
    for (int p = 0; p < NPH; ++p) { a.ph_lo = p; a.ph_hi = p + 1; hipLaunchKernelGGL(fwd_kernel, dim3(grid), dim3(NTHR), LDS_BYTES, stream, a); }
#endif
}
```

```cpp
#include <hip/hip_runtime.h>
#include <hip/hip_cooperative_groups.h>
#include <cstdio>
#include <cstdint>
#include <cmath>
namespace cg = cooperative_groups;

#ifndef MK_ONE_LAUNCH
#define MK_ONE_LAUNCH 1
#endif

#define LAS __attribute__((address_space(3)))
typedef unsigned short bf16_t;
typedef short bf16x8 __attribute__((ext_vector_type(8)));
typedef float f32x4 __attribute__((ext_vector_type(4)));
typedef float f32x2 __attribute__((ext_vector_type(2)));
typedef unsigned u32x4 __attribute__((ext_vector_type(4)));
typedef unsigned u32x2 __attribute__((ext_vector_type(2)));

constexpr int D = 1024, MTP = 16384, MTS = 1024, MT = MTP + MTS, DG = 3072, DFF = 2816, SEQ = 2048;
constexpr float EPS = 1e-6f;
constexpr int NWAVES = 8, NTHR = 512;
constexpr int LDS_BYTES = 147456;
constexpr size_t O_Y = 0, O_PCONV = (size_t)MT * D, O_PH = O_PCONV + 8 * 3 * 1024, O_SCONV = O_PH + 8 * 1024, O_SH = O_SCONV + 128 * 3 * 1024, O_SV = O_SH + 128 * 1024;
constexpr size_t MiB = 1u << 20;
constexpr size_t WS_SP = 0;
constexpr size_t WS_BAR = 65536;
constexpr size_t WS_CNT = 262144;
constexpr size_t CNT_WORDS = (4 * 2 * 64 + 4 * 4) * 64;
constexpr size_t WS_FLG = WS_CNT + CNT_WORDS * 4;
constexpr size_t CTL_ZERO_BYTES = WS_FLG + 272 * 8 * 64 - WS_BAR;
static_assert(WS_FLG + 272 * 8 * 64 <= 1u << 20, "control region");
constexpr size_t WS_RSTD = 131072;
constexpr size_t WS_ST = 1 * MiB;
constexpr size_t WS_WG3 = 5 * MiB;
constexpr size_t WS_WF1 = 11 * MiB;
constexpr size_t WS_WF2 = 22 * MiB;
constexpr size_t WS_WF1B = WS_WF2 + 5632 * 1024;
constexpr size_t WS_WF2B = WS_WF1B + 11 * MiB;
constexpr size_t WS_WR1 = 44 * MiB;
constexpr size_t WS_WR2 = 48 * MiB;
constexpr size_t WS_WAX = 50 * MiB;
constexpr size_t WS_WSB = WS_WAX + 512 * 1024;
constexpr size_t WS_TS = WS_ST;
constexpr size_t WS_U = 52 * MiB;
constexpr size_t WS_V = 154 * MiB;
constexpr size_t DO_HN = 0, DO_WG1 = 36 * MiB;
static_assert((size_t)MT * D * 2 <= DO_WG1 && DO_WG1 + (size_t)6144 * 1024 * 2 <= (size_t)MT * D * 4, "d_out scratch");
static_assert(WS_TS + (size_t)272 * 1024 * 8 <= WS_WG3 && WS_WSB + 8 * 128 * 128 * 2 <= WS_U, "ts");
static_assert(WS_U + (size_t)MT * DG * 2 <= WS_V, "U region");
static_assert(WS_V + (size_t)MT * DG * 2 <= 256 * MiB, "V region");
static_assert(WS_ST + (size_t)24 * MT * 8 <= WS_WG3, "stats");

namespace pg8 {
constexpr int BM = 256, BK = 64, HALF = 128, HTB = HALF * BK * 2, STAGE_BYTES = 8 * HTB, NXCD = 8, WGM = 8;
__host__ __device__ __forceinline__ int lds_byte(int r, int c) { const int st = (r >> 4) * 2 + (c >> 5), rr = r & 15, cc = c & 31, ob = rr * 64 + cc * 2; return st * 1024 + (ob ^ (((ob >> 9) & 1) << 5)); }
__host__ __device__ __forceinline__ void stage_rc(int b, int& R, int& C) { const int st = b / 1024, sb = b % 1024, swz = sb ^ (((sb >> 9) & 1) << 5); R = (st >> 1) * 16 + swz / 64; C = (st & 1) * 32 + (swz % 64) / 2; }
__host__ __device__ __forceinline__ int perm32(int rho) { const int n = rho >> 4, i = rho & 15; return 8 * (i >> 2) + 4 * n + (i & 3); }

struct Unit { const char* a; const char* b; int pm, pn, kind, nt, ks; };
struct Sched {
    const char *A0, *B0, *A1, *B1; int nM0, nN0, nM1, nN1, n0, nwg, G, c, ntF; size_t tstep;
    __device__ __forceinline__ void init(const void* a0, const void* b0, int M0, int N0, const void* a1, const void* b1, int M1, int N1, int K, int G_, int c_) {
        A0 = (const char*)a0; B0 = (const char*)b0; A1 = (const char*)a1; B1 = (const char*)b1; nM0 = M0 / BM; nN0 = N0 / BM; nM1 = M1 / BM; nN1 = N1 / BM;
        n0 = nM0 * nN0; nwg = n0 + nM1 * nN1; G = G_; c = c_; ntF = K / BK; tstep = (size_t)BM * K * 2; }
    __device__ __forceinline__ bool next(int i, Unit& u) const {
        const long L = (long)i * G + c; if (L >= nwg) return false;
        int wgid = (int)L; { const int q = nwg / NXCD, r = nwg % NXCD, xcd = wgid % NXCD, off = wgid / NXCD; wgid = (xcd < r ? xcd * (q + 1) : r * (q + 1) + (xcd - r) * q) + off; }
        int kind = 0, nM = nM0, nN = nN0; const char* A = A0; const char* B = B0;
        if (wgid >= n0) { wgid -= n0; kind = 1; nM = nM1; nN = nN1; A = A1; B = B1; }
        const int nig = WGM * nN, gid = wgid / nig, fm = gid * WGM, gsz = (nM - fm) < WGM ? (nM - fm) : WGM;
        u.pm = fm + ((wgid % nig) % gsz); u.pn = (wgid % nig) / gsz; u.kind = kind; u.nt = ntF; u.ks = 0; u.a = A + (size_t)u.pm * tstep; u.b = B + (size_t)u.pn * tstep; return true;
    }
};
struct SchedTail {
    const char *A, *B; int G, c, ntF, NS; size_t tstep;
    __device__ __forceinline__ void init(const void* a, const void* b, int K, int NS_, int G_, int c_) { A = (const char*)a; B = (const char*)b; G = G_; c = c_; ntF = K / BK; NS = NS_; tstep = (size_t)BM * K * 2; }
    __device__ __forceinline__ bool next(int i, Unit& u) const {
        const int yy = (c >> 3) & 7; const bool has_sub = c < 256 && yy < (NS >> 1); const int ip = has_sub ? i - 1 : i, L = ip * G + c;
        if (ip >= 0) { if (L >= 256) return false;
            u.pm = 8 * (L & 7) + ((L >> 3) & 7); u.pn = L >> 6; u.kind = 0; u.nt = ntF; u.ks = 0; u.a = A + (size_t)u.pm * tstep; u.b = B + (size_t)u.pn * tstep; return true; }
        const int r = (c & 7) + 8 * (yy + (NS >> 1) * (c >> 6));
        const int ks = r % NS, t = r / NS, hp = ntF >> 1, p0 = ks * hp / NS, p1 = (ks + 1) * hp / NS;
        u.pm = 64 + (t >> 2); u.pn = t & 3; u.kind = 1; u.ks = ks; u.nt = 2 * (p1 - p0);
        u.a = A + (size_t)u.pm * tstep + (size_t)p0 * (4 * BK); u.b = B + (size_t)u.pn * tstep + (size_t)p0 * (4 * BK); return true;
    }
};

__device__ __forceinline__ unsigned cvt_pk_bf16(float lo, float hi) { unsigned r; asm volatile("v_cvt_pk_bf16_f32 %0, %1, %2" : "=v"(r) : "v"(lo), "v"(hi)); return r; }
__device__ __forceinline__ float gelu_t(float x) {
    const float y = x * (1.0f + 0.044715f * x * x) * (-1.5957691216f * 1.4426950409f);
    return x * __builtin_amdgcn_rcpf(1.0f + __builtin_amdgcn_exp2f(y));
}
__device__ __forceinline__ float sigmoid_f(float x) { return __builtin_amdgcn_rcpf(1.0f + __builtin_amdgcn_exp2f(x * -1.4426950409f)); }
__device__ __forceinline__ f32x2 gelu2(f32x2 x) {
    const f32x2 t = (x * x) * (0.044715f * -1.5957691216f * 1.4426950409f) + (-1.5957691216f * 1.4426950409f), y = x * t;
    f32x2 e; e.x = __builtin_amdgcn_exp2f(y.x); e.y = __builtin_amdgcn_exp2f(y.y);
    const f32x2 d = e + 1.0f; f32x2 r; r.x = __builtin_amdgcn_rcpf(d.x); r.y = __builtin_amdgcn_rcpf(d.y);
    return x * r;
}
__device__ __forceinline__ f32x2 silu_mul2(f32x2 g, f32x2 u) {
    const f32x2 y = g * -1.4426950409f; f32x2 e; e.x = __builtin_amdgcn_exp2f(y.x); e.y = __builtin_amdgcn_exp2f(y.y);
    const f32x2 d = e + 1.0f; f32x2 r; r.x = __builtin_amdgcn_rcpf(d.x); r.y = __builtin_amdgcn_rcpf(d.y);
    return (g * r) * u;
}
__device__ __forceinline__ float rstd16(const float* p4) {
    const f32x4 t = *(const f32x4*)p4; return __builtin_amdgcn_rsqf(((t[0] + t[1]) + (t[2] + t[3])) * (1.f / D) + EPS); }
__device__ __forceinline__ f32x4 gelu4s(f32x4 v) { return (f32x4){gelu_t(v[0]), gelu_t(v[1]), gelu_t(v[2]), gelu_t(v[3])}; }
__device__ __forceinline__ f32x4 gelu4(f32x4 v) { const f32x2 a = gelu2((f32x2){v[0], v[1]}), b = gelu2((f32x2){v[2], v[3]}); return (f32x4){a.x, a.y, b.x, b.y}; }

template <int ACT> __device__ __forceinline__ void store_tile_bf16(const f32x4 (&acc)[2][2][4][2], int pm, int coltile, bf16_t* O, int ldc, const float* bias  , int wr, int wc, int fr, int fq, const float* rs = nullptr  , bool rs16 = false  ) {
    const int row0 = pm * BM + wr * 64 + fr, col0 = coltile + wc * 32 + 8 * fq;
    f32x4 bv[2][2];
#pragma unroll
    for (int bj = 0; bj < 2; ++bj)
#pragma unroll
        for (int n = 0; n < 2; ++n) bv[bj][n] = bias ? *(const f32x4*)(bias + wc * 32 + 8 * fq + bj * HALF + 4 * n) : (f32x4){0.f, 0.f, 0.f, 0.f};
#pragma unroll
    for (int ai = 0; ai < 2; ++ai)
#pragma unroll
        for (int m = 0; m < 4; ++m) { bf16_t* rowp = O + (size_t)(row0 + ai * HALF + m * 16) * ldc + col0; const float rsv = rs ? (rs16 ? rstd16(rs + (size_t)(row0 + ai * HALF + m * 16) * 4) : rs[row0 + ai * HALF + m * 16]) : 1.0f;
#pragma unroll
            for (int bj = 0; bj < 2; ++bj) { f32x4 v0 = acc[ai][bj][m][0] * rsv + bv[bj][0], v1 = acc[ai][bj][m][1] * rsv + bv[bj][1];
                if (ACT == 1) { v0 = gelu4s(v0); v1 = gelu4s(v1); }
                if (ACT == 2) { v0 = gelu4(v0); v1 = gelu4(v1); }
                u32x4 w; w.x = cvt_pk_bf16(v0[0], v0[1]); w.y = cvt_pk_bf16(v0[2], v0[3]); w.z = cvt_pk_bf16(v1[0], v1[1]); w.w = cvt_pk_bf16(v1[2], v1[3]);
                *(u32x4*)(rowp + bj * HALF) = w; } }
}

struct EpiPlain {
    bf16_t* O; int ldc;
    __device__ __forceinline__ void operator()(const f32x4 (&acc)[2][2][4][2], const Unit& u, int wr, int wc, int fr, int fq) const { store_tile_bf16<0>(acc, u.pm, u.pn * BM, O, ldc, nullptr, wr, wc, fr, fq); }
};
struct EpiTail {
    bf16_t* O; float* PB;
    __device__ __forceinline__ void operator()(const f32x4 (&acc)[2][2][4][2], const Unit& u, int wr, int wc, int fr, int fq) const {
        if (u.kind == 0) { store_tile_bf16<0>(acc, u.pm, u.pn * BM, O, D, nullptr, wr, wc, fr, fq); return; }
        float* base = PB + (size_t)u.ks * (MTS * D) + (size_t)((u.pm - 64) * BM + wr * 64 + fr) * D + u.pn * BM + wc * 32 + 8 * fq;
#pragma unroll
        for (int ai = 0; ai < 2; ++ai)
#pragma unroll
            for (int m = 0; m < 4; ++m)
#pragma unroll
                for (int bj = 0; bj < 2; ++bj) { float* p = base + (size_t)(ai * HALF + m * 16) * D + bj * HALF; *(f32x4*)p = acc[ai][bj][m][0]; *(f32x4*)(p + 4) = acc[ai][bj][m][1]; }
    }
};
struct RmsExchange {
    float* xbuf; unsigned* cnt;
    __device__ __forceinline__ void publish(const f32x4 (&v)[2][2][4][2], int pm, int pn, int wr, int wc, int fr, int fq, LAS unsigned char* lds) const {
        LAS float* P = (LAS float*)lds;
        const int wid = wr * 4 + wc, lane = fq * 16 + fr;
#pragma unroll
        for (int ai = 0; ai < 2; ++ai)
#pragma unroll
            for (int m = 0; m < 4; ++m) { float s = 0.f;
#pragma unroll
                for (int bj = 0; bj < 2; ++bj)
#pragma unroll
                    for (int n = 0; n < 2; ++n) { const f32x4 x = v[ai][bj][m][n]; s += (x[0] * x[0] + x[1] * x[1]) + (x[2] * x[2] + x[3] * x[3]); }
                s += __shfl_xor(s, 16); s += __shfl_xor(s, 32);
                if (fq == 0) P[(ai * HALF + wr * 64 + m * 16 + fr) * 4 + wc] = s; }
        asm volatile("s_waitcnt lgkmcnt(0)" ::: "memory"); __builtin_amdgcn_s_barrier(); asm volatile("" ::: "memory");
        const int row = wid * 32 + (lane & 31);
        if (lane < 32) { const float t = (P[row * 4 + 0] + P[row * 4 + 1]) + (P[row * 4 + 2] + P[row * 4 + 3]);
            __hip_atomic_store(xbuf + ((size_t)(pm * BM + row) * 4 + pn), t, __ATOMIC_RELAXED, __HIP_MEMORY_SCOPE_AGENT); }
        asm volatile("s_waitcnt vmcnt(0)" ::: "memory");
        if (lane == 0) __hip_atomic_fetch_add(cnt + 64 * pm, 1u, __ATOMIC_RELAXED, __HIP_MEMORY_SCOPE_AGENT);
    }
    __device__ __forceinline__ void wait(int pm, int pn, int wr, int wc, int fr, int fq, LAS unsigned char* lds, float* rstd_out  ) const {
        LAS float* S = (LAS float*)(lds + 4096);
        const int wid = wr * 4 + wc, lane = fq * 16 + fr, row = wid * 32 + (lane & 31);
        if (wid == 0) { unsigned sp = 0;
            while ((unsigned)__builtin_amdgcn_readfirstlane(__hip_atomic_load(cnt + 64 * pm, __ATOMIC_RELAXED, __HIP_MEMORY_SCOPE_AGENT)) < 32u) { __builtin_amdgcn_s_sleep(2); if (++sp > (1u << 22)) break; }
            __builtin_amdgcn_fence(__ATOMIC_ACQUIRE, "agent"); }
        asm volatile("s_waitcnt vmcnt(0) lgkmcnt(0)" ::: "memory"); __builtin_amdgcn_s_barrier(); asm volatile("" ::: "memory");
        if (lane < 32) { const float* slot = xbuf + (size_t)(pm * BM + row) * 4; float t = 0.f;
#pragma unroll
            for (int k = 0; k < 4; ++k) t += __hip_atomic_load(slot + k, __ATOMIC_RELAXED, __HIP_MEMORY_SCOPE_AGENT);
            const float rs = __builtin_amdgcn_rsqf(t * (1.f / D) + EPS); S[row] = rs;
            if (rstd_out && pn == 0) rstd_out[pm * BM + row] = rs; }
        asm volatile("s_waitcnt lgkmcnt(0)" ::: "memory"); __builtin_amdgcn_s_barrier(); asm volatile("" ::: "memory");
    }
};
template <bool FINAL> struct EpiTailFused {
    bf16_t* PB; unsigned* scnt  ; RmsExchange e1; const bf16_t* XBin  ; bf16_t* XB  ; const float* g1; float* outf; float* RSTD  ; LAS unsigned char* ldsx;
    static __device__ __forceinline__ void unpack8(f32x4& a, f32x4& b, u32x4 w) {
        a = (f32x4){__builtin_bit_cast(float, w.x << 16), __builtin_bit_cast(float, w.x & 0xffff0000u), __builtin_bit_cast(float, w.y << 16), __builtin_bit_cast(float, w.y & 0xffff0000u)};
        b = (f32x4){__builtin_bit_cast(float, w.z << 16), __builtin_bit_cast(float, w.z & 0xffff0000u), __builtin_bit_cast(float, w.w << 16), __builtin_bit_cast(float, w.w & 0xffff0000u)}; }
    __device__ __forceinline__ void operator()(f32x4 (&acc)[2][2][4][2], const Unit& u, int wr, int wc, int fr, int fq) const {
        if (u.kind == 1) {
            bf16_t* base = PB + (size_t)u.ks * (MTS * D) + (size_t)((u.pm - 64) * BM + wr * 64 + fr) * D + u.pn * BM + wc * 32 + 8 * fq;
#pragma unroll
            for (int ai = 0; ai < 2; ++ai)
#pragma unroll
                for (int m = 0; m < 4; ++m)
#pragma unroll
                    for (int bj = 0; bj < 2; ++bj) { const f32x4 v0 = acc[ai][bj][m][0], v1 = acc[ai][bj][m][1]; u32x4 w; w.x = cvt_pk_bf16(v0[0], v0[1]); w.y = cvt_pk_bf16(v0[2], v0[3]); w.z = cvt_pk_bf16(v1[0], v1[1]); w.w = cvt_pk_bf16(v1[2], v1[3]);
                        *(u32x4*)(base + (size_t)(ai * HALF + m * 16) * D + bj * HALF) = w; }
            asm volatile("s_waitcnt vmcnt(0)" ::: "memory"); __builtin_amdgcn_s_barrier(); asm volatile("" ::: "memory");
            if (threadIdx.x == 0) { __builtin_amdgcn_fence(__ATOMIC_RELEASE, "agent"); asm volatile("s_waitcnt vmcnt(0)" ::: "memory");
                __hip_atomic_fetch_add(scnt + 64 * (u.pm - 64), 1u, __ATOMIC_RELAXED, __HIP_MEMORY_SCOPE_AGENT); }
            return; }
        const LAS float* S = (const LAS float*)(ldsx + 4096);
        const int col0 = u.pn * BM + wc * 32 + 8 * fq;
        e1.publish(acc, u.pm, u.pn, wr, wc, fr, fq, ldsx);
        u32x4 pre[4][2];
#pragma unroll
        for (int m = 0; m < 4; ++m)
#pragma unroll
            for (int bj = 0; bj < 2; ++bj) pre[m][bj] = *(const u32x4*)(XBin + (size_t)(u.pm * BM + wr * 64 + m * 16 + fr) * D + col0 + bj * HALF);
        f32x4 gv[2][2];
#pragma unroll
        for (int bj = 0; bj < 2; ++bj)
#pragma unroll
            for (int n = 0; n < 2; ++n) gv[bj][n] = *(const f32x4*)(g1 + col0 + bj * HALF + 4 * n);
        e1.wait(u.pm, u.pn, wr, wc, fr, fq, ldsx, nullptr);
#pragma unroll
        for (int ai = 0; ai < 2; ++ai)
#pragma unroll
            for (int m = 0; m < 4; ++m) { const int row = ai * HALF + wr * 64 + m * 16 + fr; const float rs = S[row]; const size_t off = (size_t)(u.pm * BM + row) * D + col0; float s2 = 0.f;
#pragma unroll
                for (int bj = 0; bj < 2; ++bj) { f32x4 x0, x1; unpack8(x0, x1, ai == 0 ? pre[m][bj] : *(const u32x4*)(XBin + off + bj * HALF));
                    const f32x4 v0 = x0 + acc[ai][bj][m][0] * rs * gv[bj][0], v1 = x1 + acc[ai][bj][m][1] * rs * gv[bj][1];
                    s2 += ((v0[0] * v0[0] + v0[1] * v0[1]) + (v0[2] * v0[2] + v0[3] * v0[3])) + ((v1[0] * v1[0] + v1[1] * v1[1]) + (v1[2] * v1[2] + v1[3] * v1[3]));
                    if (FINAL) { *(f32x4*)(outf + off + bj * HALF) = v0; *(f32x4*)(outf + off + bj * HALF + 4) = v1; }
                    else { u32x4 w; w.x = cvt_pk_bf16(v0[0], v0[1]); w.y = cvt_pk_bf16(v0[2], v0[3]); w.z = cvt_pk_bf16(v1[0], v1[1]); w.w = cvt_pk_bf16(v1[2], v1[3]); *(u32x4*)(XB + off + bj * HALF) = w; } }
                if (!FINAL) { s2 += __shfl_xor(s2, 16); s2 += __shfl_xor(s2, 32);
                    if (fq == 0) ((LAS float*)ldsx)[row * 4 + wc] = s2; }
                if (m == 3) asm volatile("" ::: "memory"); }
        if (!FINAL) {
            asm volatile("s_waitcnt lgkmcnt(0)" ::: "memory"); __builtin_amdgcn_s_barrier(); asm volatile("" ::: "memory");
            const int wid = wr * 4 + wc, lane = fq * 16 + fr, row = wid * 32 + (lane & 31); const LAS float* P = (const LAS float*)ldsx;
            if (lane < 32) RSTD[(size_t)(u.pm * BM + row) * 4 + u.pn] = (P[row * 4 + 0] + P[row * 4 + 1]) + (P[row * 4 + 2] + P[row * 4 + 3]);
            asm volatile("s_waitcnt lgkmcnt(0)" ::: "memory"); __builtin_amdgcn_s_barrier(); asm volatile("" ::: "memory");
        }
    }
};
struct EpiG6 {
    bf16_t* GATE; bf16_t* XBR; const float* rs;
    __device__ __forceinline__ void operator()(const f32x4 (&acc)[2][2][4][2], const Unit& u, int wr, int wc, int fr, int fq) const {
        if (u.pn < 4) store_tile_bf16<2>(acc, u.pm, u.pn * BM, GATE, D, nullptr, wr, wc, fr, fq, rs, true);
        else store_tile_bf16<0>(acc, u.pm, (u.pn - 4) * BM, XBR, D, nullptr, wr, wc, fr, fq, rs, true);
    }
};
struct EpiSwiglu {
    bf16_t* H; const float* rs;
    __device__ __forceinline__ void operator()(const f32x4 (&acc)[2][2][4][2], const Unit& u, int wr, int wc, int fr, int fq) const {
        const int row0 = u.pm * BM + wr * 64 + fr, col0 = u.pn * HALF + wc * 32 + 8 * fq;
#pragma unroll
        for (int ai = 0; ai < 2; ++ai)
#pragma unroll
            for (int m = 0; m < 4; ++m) { bf16_t* rowp = H + (size_t)(row0 + ai * HALF + m * 16) * DFF + col0; f32x4 o[2]; const float rsv = rstd16(rs + (size_t)(row0 + ai * HALF + m * 16) * 4);
#pragma unroll
                for (int n = 0; n < 2; ++n) { const f32x4 g = acc[ai][0][m][n] * rsv, uu = acc[ai][1][m][n] * rsv;
                    const f32x2 a = silu_mul2((f32x2){g[0], g[1]}, (f32x2){uu[0], uu[1]}), b = silu_mul2((f32x2){g[2], g[3]}, (f32x2){uu[2], uu[3]}); o[n] = (f32x4){a.x, a.y, b.x, b.y}; }
                u32x4 w; w.x = cvt_pk_bf16(o[0][0], o[0][1]); w.y = cvt_pk_bf16(o[0][2], o[0][3]); w.z = cvt_pk_bf16(o[1][0], o[1][1]); w.w = cvt_pk_bf16(o[1][2], o[1][3]);
                *(u32x4*)rowp = w; }
    }
};
__device__ __forceinline__ float row16_sum_lane0(float v) {
    v += __builtin_bit_cast(float, __builtin_amdgcn_update_dpp(0, __builtin_bit_cast(int, v), 0x108, 0xf, 0xf, true));
    v += __builtin_bit_cast(float, __builtin_amdgcn_update_dpp(0, __builtin_bit_cast(int, v), 0x104, 0xf, 0xf, true));
    v += __builtin_bit_cast(float, __builtin_amdgcn_update_dpp(0, __builtin_bit_cast(int, v), 0x102, 0xf, 0xf, true));
    v += __builtin_bit_cast(float, __builtin_amdgcn_update_dpp(0, __builtin_bit_cast(int, v), 0x101, 0xf, 0xf, true));
    return v;
}
struct EpiG1 {
    bf16_t* U; bf16_t* VT; const float* b_in; f32x2* ST; const float* rs;
    __device__ __forceinline__ void operator()(const f32x4 (&acc)[2][2][4][2], const Unit& u, int wr, int wc, int fr, int fq) const {
        if (u.kind == 0) { store_tile_bf16<2>(acc, u.pm, u.pn * BM, U, DG, b_in + u.pn * BM, wr, wc, fr, fq, rs); return; }
        const int row0 = u.pm * BM + wr * 64 + fr, col0 = u.pn * BM + wc * 32 + 8 * fq;
#pragma unroll
        for (int bj = 0; bj < 2; ++bj) {
            float cs[2][4], cq[2][4]; const f32x4 rc0 = *(const f32x4*)(rs + col0 + bj * HALF), rc1 = *(const f32x4*)(rs + col0 + bj * HALF + 4);
#pragma unroll
            for (int n = 0; n < 2; ++n)
#pragma unroll
                for (int j = 0; j < 4; ++j) { cs[n][j] = 0.f; cq[n][j] = 0.f; }
#pragma unroll
            for (int ai = 0; ai < 2; ++ai)
#pragma unroll
                for (int m = 0; m < 4; ++m) { const int row = row0 + ai * HALF + m * 16; const float bv = b_in[DG + row]; bf16_t* rowp = VT + (size_t)row * MT + col0 + bj * HALF;
                    { const f32x4 v0 = gelu4s(acc[ai][bj][m][0] * rc0 + bv);
#pragma unroll
                      for (int j = 0; j < 4; ++j) { cs[0][j] += v0[j]; cq[0][j] += v0[j] * v0[j]; }
                      u32x2 w; w.x = cvt_pk_bf16(v0[0], v0[1]); w.y = cvt_pk_bf16(v0[2], v0[3]); *(u32x2*)rowp = w; }
                    { const f32x4 v1 = gelu4s(acc[ai][bj][m][1] * rc1 + bv);
#pragma unroll
                      for (int j = 0; j < 4; ++j) { cs[1][j] += v1[j]; cq[1][j] += v1[j] * v1[j]; }
                      u32x2 w; w.x = cvt_pk_bf16(v1[0], v1[1]); w.y = cvt_pk_bf16(v1[2], v1[3]); *(u32x2*)(rowp + 4) = w; } }
#pragma unroll
            for (int n = 0; n < 2; ++n) {
#pragma unroll
                for (int j = 0; j < 4; ++j) { cs[n][j] = row16_sum_lane0(cs[n][j]); cq[n][j] = row16_sum_lane0(cq[n][j]); }
                if (fr == 0) { f32x2* sp = ST + (size_t)(u.pm * 2 + wr) * MT + col0 + bj * HALF + 4 * n;
                    *(f32x4*)(sp) = (f32x4){cs[n][0], cq[n][0], cs[n][1], cq[n][1]};
                    *(f32x4*)(sp + 2) = (f32x4){cs[n][2], cq[n][2], cs[n][3], cq[n][3]}; } }
            asm volatile("" ::: "memory");
        }
    }
};

template <class Epi, class SchedT>
__device__ __forceinline__ void gemm_phase(LAS unsigned char* lds, const int K, const SchedT& S, const Epi& E) {
    const int tid = threadIdx.x, wid = __builtin_amdgcn_readfirstlane(tid >> 6), lane = tid & 63, wr = wid >> 2, wc = wid & 3, fr = lane & 15, fq = lane >> 4;
    unsigned voffA[2], voffB[2];
#pragma unroll
    for (int i = 0; i < 2; ++i) { int R, C; stage_rc(tid * 16 + i * 8192, R, C); const int Rb = (R & ~31) + perm32(R & 31);
        voffA[i] = (unsigned)(R * K + C) * 2u; voffB[i] = (unsigned)(Rb * K + C) * 2u; }
    const size_t kstep = (size_t)(BK * 2);
    const size_t hstep = (size_t)HALF * K * 2;
    const unsigned ldsw = (unsigned)wid * 1024u;
    const int aoff = lds_byte(wr * 64 + fr, fq * 8), boff = lds_byte(wc * 32 + fr, fq * 8);
#define PG8_SA(b, h) (((b) * 2 + (h)) * HTB)
#define PG8_SB(b, h) ((4 + (b) * 2 + (h)) * HTB)
#define PG8_STAGE(bufoff, gbase, voff) do { _Pragma("unroll") for (int _i = 0; _i < 2; ++_i) \
        __builtin_amdgcn_global_load_lds((const unsigned*)((const char*)(gbase) + (voff)[_i]), (LAS unsigned*)(lds + (bufoff) + ldsw + _i * 8192), 16, 0, 0); } while (0)
#define PG8_LDA(dst, b, h) do { _Pragma("unroll") for (int m = 0; m < 4; ++m) _Pragma("unroll") for (int k = 0; k < 2; ++k) dst[m][k] = *(const LAS bf16x8*)(lds + PG8_SA(b, h) + aoff + m * 2048 + k * 1024); } while (0)
#define PG8_LDB(dst, b, h) do { _Pragma("unroll") for (int n = 0; n < 2; ++n) _Pragma("unroll") for (int k = 0; k < 2; ++k) dst[n][k] = *(const LAS bf16x8*)(lds + PG8_SB(b, h) + boff + n * 2048 + k * 1024); } while (0)
#define PG8_MMA(ai, bj, At, Bt) do { __builtin_amdgcn_s_setprio(1); _Pragma("unroll") for (int m = 0; m < 4; ++m) _Pragma("unroll") for (int n = 0; n < 2; ++n) _Pragma("unroll") for (int k = 0; k < 2; ++k) \
        acc[ai][bj][m][n] = __builtin_amdgcn_mfma_f32_16x16x32_bf16(Bt[n][k], At[m][k], acc[ai][bj][m][n], 0, 0, 0); __builtin_amdgcn_s_setprio(0); } while (0)
#define PG8_WAIT_V(n) asm volatile("s_waitcnt vmcnt(" #n ")" ::: "memory")
#define PG8_WAIT_L(n) asm volatile("s_waitcnt lgkmcnt(" #n ")" ::: "memory")
#define PG8_BAR __builtin_amdgcn_s_barrier()
#define PG8_SCHED __builtin_amdgcn_sched_barrier(0)
    Unit cur, nxt; int ui = 0;
    if (!S.next(0, cur)) return;
    f32x4 acc[2][2][4][2];
#pragma unroll
    for (int a = 0; a < 2; ++a)
#pragma unroll
        for (int b = 0; b < 2; ++b)
#pragma unroll
            for (int m = 0; m < 4; ++m)
#pragma unroll
                for (int n = 0; n < 2; ++n) acc[a][b][m][n] = (f32x4){0.f, 0.f, 0.f, 0.f};
    bf16x8 At[4][2], B0[2][2], B1[2][2];
    const char* cA = cur.a; const char* cB = cur.b;
    PG8_WAIT_V(0);
    PG8_STAGE(PG8_SB(0, 0), cB, voffB); PG8_STAGE(PG8_SB(0, 1), cB + hstep, voffB); PG8_STAGE(PG8_SA(0, 0), cA, voffA); PG8_STAGE(PG8_SA(0, 1), cA + hstep, voffA);
    if (wr == 1) PG8_BAR;
    PG8_WAIT_V(2); PG8_BAR;
    PG8_STAGE(PG8_SB(1, 0), cB + kstep, voffB); PG8_STAGE(PG8_SA(1, 0), cA + kstep, voffA); PG8_STAGE(PG8_SB(1, 1), cB + hstep + kstep, voffB);
    PG8_WAIT_V(6); PG8_BAR;
    for (;;) {
        const bool has_next = S.next(ui + 1, nxt); const int nt = cur.nt;
        const char* nA = has_next ? nxt.a : cA; const char* nB = has_next ? nxt.b : cB;
        for (int t = 0; t < nt; t += 2) {
            const bool last = (t == nt - 2);
            const char* a1 = cA + (size_t)(t + 1) * kstep;
            const char* a2 = last ? nA : cA + (size_t)(t + 2) * kstep; const char* b2 = last ? nB : cB + (size_t)(t + 2) * kstep;
            const char* a3 = a2 + kstep; const char* b3 = b2 + kstep;
            PG8_LDB(B0, 0, 0); PG8_LDB(B1, 0, 1); PG8_SCHED; PG8_LDA(At, 0, 0); PG8_STAGE(PG8_SA(1, 1), a1 + hstep, voffA);
            PG8_WAIT_V(8); PG8_WAIT_L(0); PG8_BAR; PG8_MMA(0, 0, At, B0); PG8_MMA(0, 1, At, B1); PG8_BAR; PG8_SCHED;
            PG8_LDA(At, 0, 1); PG8_STAGE(PG8_SB(0, 0), b2, voffB); PG8_STAGE(PG8_SB(0, 1), b2 + hstep, voffB); PG8_STAGE(PG8_SA(0, 0), a2, voffA);
            PG8_WAIT_V(8); PG8_WAIT_L(0); PG8_BAR; PG8_MMA(1, 0, At, B0); PG8_MMA(1, 1, At, B1); PG8_BAR; PG8_SCHED;
            PG8_LDB(B0, 1, 0); PG8_LDB(B1, 1, 1); PG8_SCHED; PG8_LDA(At, 1, 0); PG8_STAGE(PG8_SA(0, 1), a2 + hstep, voffA);
            PG8_WAIT_V(8); PG8_WAIT_L(0); PG8_BAR; PG8_MMA(0, 0, At, B0); PG8_MMA(0, 1, At, B1); PG8_BAR; PG8_SCHED;
            PG8_LDA(At, 1, 1); PG8_STAGE(PG8_SB(1, 0), b3, voffB); PG8_STAGE(PG8_SB(1, 1), b3 + hstep, voffB); PG8_STAGE(PG8_SA(1, 0), a3, voffA);
            PG8_WAIT_V(8); PG8_WAIT_L(0); PG8_BAR; PG8_MMA(1, 0, At, B0); PG8_MMA(1, 1, At, B1); PG8_BAR; PG8_SCHED;
        }
        if (wr == 0) PG8_BAR;
        E(acc, cur, wr, wc, fr, fq);
        if (!has_next) break;
#pragma unroll
        for (int a = 0; a < 2; ++a)
#pragma unroll
            for (int b = 0; b < 2; ++b)
#pragma unroll
                for (int m = 0; m < 4; ++m)
#pragma unroll
                    for (int n = 0; n < 2; ++n) acc[a][b][m][n] = (f32x4){0.f, 0.f, 0.f, 0.f};
        cur = nxt; cA = nA; cB = nB; ++ui;
        if (wr == 1) PG8_BAR;
    }
    PG8_WAIT_V(0);
    PG8_BAR;
#undef PG8_SA
#undef PG8_SB
#undef PG8_STAGE
#undef PG8_LDA
#undef PG8_LDB
#undef PG8_MMA
#undef PG8_WAIT_V
#undef PG8_WAIT_L
#undef PG8_BAR
#undef PG8_SCHED
}
}

#define LDS_WAIT() asm volatile("s_waitcnt lgkmcnt(0)" ::: "memory")
__device__ __forceinline__ unsigned f2bf(float f) { unsigned u = __builtin_bit_cast(unsigned, f); return (u + 0x7fffu + ((u >> 16) & 1u)) >> 16; }
__device__ __forceinline__ unsigned pk2(float lo, float hi) { return pg8::cvt_pk_bf16(lo, hi); }
__device__ __forceinline__ bf16_t f2bf1(float f) { return (bf16_t)(pg8::cvt_pk_bf16(f, f) & 0xffffu); }
__device__ __forceinline__ float bflo(unsigned w) { return __builtin_bit_cast(float, w << 16); }
__device__ __forceinline__ float bfhi(unsigned w) { return __builtin_bit_cast(float, w & 0xffff0000u); }
__device__ __forceinline__ float wave_sum(float v) {
#pragma unroll
    for (int o = 1; o < 64; o <<= 1) v += __shfl_xor(v, o);
    return v;
}

#define XB_TMO      128
#define XB_XCNT(j)  (256  + 64 * (j))
#define XB_XSUB(j)  (1280 + 64 * (j))
#define XB_XGEN(j)  (2304 + 64 * (j))
#define XB_TOP      3328
#define XB_TOPGEN   3392
#define XCD_BAR_WORDS 3456
#define XB_SPIN_CAP (1u << 18)

__device__ __forceinline__ unsigned xb_ld(unsigned* p)              { return __hip_atomic_load(p, __ATOMIC_RELAXED, __HIP_MEMORY_SCOPE_AGENT); }
__device__ __forceinline__ unsigned xb_add(unsigned* p, unsigned v) { return __hip_atomic_fetch_add(p, v, __ATOMIC_RELAXED, __HIP_MEMORY_SCOPE_AGENT); }
__device__ __forceinline__ unsigned xb_xcc_id() { return (unsigned)__builtin_amdgcn_s_getreg((3 << 11) | 20) & 0xFu; }
#define XB_SPIN(cond, bar) do { unsigned _sp = 0; while (cond) { __builtin_amdgcn_s_sleep(1); \
    if ((++_sp & 255u) == 0u) { if (xb_ld(&(bar)[XB_TMO])) break; if (_sp > XB_SPIN_CAP) { atomicAdd(&(bar)[XB_TMO], 1u); break; } } } } while (0)

struct XcdBarrier {
    unsigned* bar; unsigned x;
    volatile LAS unsigned* st;
};

__device__ __forceinline__ XcdBarrier xcd_barrier_post(unsigned* bar, volatile LAS unsigned* st) {
    XcdBarrier b; b.bar = bar; b.x = xb_xcc_id(); b.st = st;
    if (threadIdx.x == 0) (void)xb_add(&bar[XB_XCNT(b.x)], 1u);
    return b;
}
__device__ __forceinline__ void xcd_barrier_complete(unsigned* bar, unsigned x, unsigned& nloc, unsigned& nx) {
    const unsigned G = gridDim.x * gridDim.y * gridDim.z;
    unsigned sum, cnt, mine, sp = 0u;
    for (;;) {
        sum = 0u; cnt = 0u; mine = 0u;
#pragma unroll
        for (unsigned j = 0; j < 16; ++j) { const unsigned c = xb_ld(&bar[XB_XCNT(j)]); sum += c; cnt += (c > 0u) ? 1u : 0u; mine = (j == x) ? c : mine; }
        if (sum == G) break;
        __builtin_amdgcn_s_sleep(1);
        if ((++sp & 255u) == 0u) { if (xb_ld(&bar[XB_TMO])) break; if (sp > XB_SPIN_CAP) { atomicAdd(&bar[XB_TMO], 1u); break; } }
    }
    nloc = mine > 0u ? mine : 1u; nx = cnt > 0u ? cnt : 1u;
}

__device__ __forceinline__ void xcd_barrier(const XcdBarrier& b) {
    asm volatile("s_waitcnt vmcnt(0)" ::: "memory");
    __syncthreads();
    if (threadIdx.x == 0) {
        unsigned* bar = b.bar;
        __builtin_amdgcn_s_waitcnt(0);
        unsigned nloc = b.st[0], nx = b.st[1];
        if (nloc == 0u) { xcd_barrier_complete(bar, b.x, nloc, nx); b.st[0] = nloc; b.st[1] = nx; }
        const unsigned old = xb_add(&bar[XB_XSUB(b.x)], 1u);
        const unsigned gen = old / nloc;
        if (old + 1u == (gen + 1u) * nloc) {
            __builtin_amdgcn_fence(__ATOMIC_RELEASE, "agent");
            asm volatile("s_waitcnt vmcnt(0)" ::: "memory");
            const unsigned og = xb_add(&bar[XB_TOP], 1u);
            const unsigned tg = og / nx;
            if (og + 1u == (tg + 1u) * nx) xb_add(&bar[XB_TOPGEN], 1u);
            else XB_SPIN(xb_ld(&bar[XB_TOPGEN]) == tg, bar);
            __builtin_amdgcn_fence(__ATOMIC_ACQUIRE, "agent");
            xb_add(&bar[XB_XGEN(b.x)], 1u);
            asm volatile("s_waitcnt vmcnt(0)" ::: "memory");
        } else {
            XB_SPIN(xb_ld(&bar[XB_XGEN(b.x)]) == gen, bar);
            __builtin_amdgcn_fence(__ATOMIC_ACQUIRE, "agent");
            asm volatile("s_waitcnt vmcnt(0)" ::: "memory");
        }
    }
    __syncthreads();
}


struct Ctx {
    LAS unsigned char* lds; int tid, lane, wave, vcu, G;
    float* out; unsigned char* ws;
};
struct Args { const float* in[23]; float* out; unsigned char* ws; int ph_lo, ph_hi; };
#define CIN(k) (A.in[k])

template <int MAP> __device__ __forceinline__ void p0_transpose_item(const float* W, int K, int N, bf16_t* WT, int row_off, LAS float* scr, int item, int lane, const float* gk = nullptr  ) {
    const int nblk = N / 32, kb = item / nblk, nb = item % nblk, k0 = 64 * kb, n0 = 32 * nb;
#pragma unroll 8
    for (int i = 0; i < 32; ++i) { const int kk = 2 * i + (lane >> 5); scr[kk * 33 + (lane & 31)] = W[(size_t)(k0 + kk) * N + n0 + (lane & 31)] * (gk ? gk[k0 + kk] : 1.0f); }
    LDS_WAIT(); asm volatile("" ::: "memory");
    int r0 = row_off + n0;
    if (MAP == 1) { const int half = n0 / DFF, f = n0 % DFF; r0 = (f / 128) * 256 + half * 128 + (f % 128); }
    const int c = lane & 7;
#pragma unroll
    for (int j = 0; j < 4; ++j) { const int n = (lane >> 3) + 8 * j; const LAS float* s = scr + (8 * c) * 33 + n;
        u32x4 o; o.x = pk2(s[0 * 33], s[1 * 33]); o.y = pk2(s[2 * 33], s[3 * 33]); o.z = pk2(s[4 * 33], s[5 * 33]); o.w = pk2(s[6 * 33], s[7 * 33]);
        *(u32x4*)(WT + (size_t)(r0 + n) * K + k0 + 8 * c) = o; }
    LDS_WAIT(); asm volatile("" ::: "memory");
}

__device__ __forceinline__ void ld8_bf16(f32x4& a, f32x4& b, const bf16_t* p) { const u32x4 w = *(const u32x4*)p; a = (f32x4){bflo(w.x), bfhi(w.x), bflo(w.y), bfhi(w.y)}; b = (f32x4){bflo(w.z), bfhi(w.z), bflo(w.w), bfhi(w.w)}; }
template <bool XIN_F32, bool HAS_MM> __device__ __forceinline__ void row_load(f32x4 (&v)[4], f32x4 (&m)[4], const void* xin, const bf16_t* mm, const bf16_t* pb, int ns, int lane) {
#pragma unroll
    for (int j = 0; j < 2; ++j) { const int e = 8 * lane + 512 * j;
        if (XIN_F32) { v[2 * j] = *(const f32x4*)((const float*)xin + e); v[2 * j + 1] = *(const f32x4*)((const float*)xin + e + 4); }
        else ld8_bf16(v[2 * j], v[2 * j + 1], (const bf16_t*)xin + e); }
    if (HAS_MM) {
#pragma unroll
        for (int j = 0; j < 2; ++j) { const int e = 8 * lane + 512 * j;
            if (pb) { ld8_bf16(m[2 * j], m[2 * j + 1], pb + e);
                for (int k = 1; k < ns; ++k) { f32x4 a, b; ld8_bf16(a, b, pb + (size_t)k * (MTS * D) + e); m[2 * j] = m[2 * j] + a; m[2 * j + 1] = m[2 * j + 1] + b; } }
            else ld8_bf16(m[2 * j], m[2 * j + 1], mm + e); }
    }
}
template <bool HAS_MM, bool OUT_F32, int WANT_RSTD  > __device__ __forceinline__ void row_finish(f32x4 (&v)[4], const f32x4 (&m)[4], const f32x4 (&g)[4], void* xout, float* rstd_out, int lane) {
    if (HAS_MM) {
        float s = 0.f;
#pragma unroll
        for (int j = 0; j < 4; ++j) s += (m[j].x * m[j].x + m[j].y * m[j].y) + (m[j].z * m[j].z + m[j].w * m[j].w);
        const float rs = __builtin_amdgcn_rsqf(wave_sum(s) * (1.f / D) + EPS);
#pragma unroll
        for (int j = 0; j < 4; ++j) v[j] = v[j] + m[j] * rs * g[j];
    }
#pragma unroll
    for (int j = 0; j < 2; ++j) { const int e = 8 * lane + 512 * j;
        if (OUT_F32) { *(f32x4*)((float*)xout + e) = v[2 * j]; *(f32x4*)((float*)xout + e + 4) = v[2 * j + 1]; }
        else { u32x4 w; w.x = pg8::cvt_pk_bf16(v[2 * j].x, v[2 * j].y); w.y = pg8::cvt_pk_bf16(v[2 * j].z, v[2 * j].w); w.z = pg8::cvt_pk_bf16(v[2 * j + 1].x, v[2 * j + 1].y); w.w = pg8::cvt_pk_bf16(v[2 * j + 1].z, v[2 * j + 1].w);
            *(u32x4*)((bf16_t*)xout + e) = w; } }
    if (WANT_RSTD) {
        float s = 0.f;
#pragma unroll
        for (int j = 0; j < 4; ++j) s += (v[j].x * v[j].x + v[j].y * v[j].y) + (v[j].z * v[j].z + v[j].w * v[j].w);
        const float tot = wave_sum(s);
        if (WANT_RSTD == 2) { if (lane < 4) rstd_out[lane] = lane == 0 ? tot : 0.f; }
        else if (lane == 0) rstd_out[0] = __builtin_amdgcn_rsqf(tot * (1.f / D) + EPS);
    }
}
template <bool XIN_F32, bool HAS_MM, bool OUT_F32, bool WANT_RSTD> __device__ __forceinline__ void row_op(const void* xin, const bf16_t* mm, const bf16_t* pb, int ns, const float* g1, void* xout, float* rstd_out, int lane) {
    f32x4 v[4], m[4], g[4];
#pragma unroll
    for (int j = 0; j < 4; ++j) g[j] = HAS_MM ? *(const f32x4*)(g1 + 8 * lane + 512 * (j >> 1) + 4 * (j & 1)) : (f32x4){0.f, 0.f, 0.f, 0.f};
    row_load<XIN_F32, HAS_MM>(v, m, xin, mm, pb, ns, lane);
    row_finish<HAS_MM, OUT_F32, WANT_RSTD>(v, m, g, xout, rstd_out, lane);
}
template <int XSRC, bool OUT_F32, bool WANT_RSTD> __device__ __forceinline__ void rowop_phase(const float* xp, const float* xs, bf16_t* XB, const bf16_t* MMb, const bf16_t* PB, int ns, const float* g1, float* outf, float* RSTD, int gw, int NGW, int lane) {
    f32x4 g[4];
#pragma unroll
    for (int j = 0; j < 4; ++j) g[j] = *(const f32x4*)(g1 + 8 * lane + 512 * (j >> 1) + 4 * (j & 1));
    for (int m0 = gw; m0 < MT; m0 += 2 * NGW) {
        const int m1 = m0 + NGW; const bool has1 = m1 < MT;
        f32x4 v0[4], q0[4], v1[4], q1[4];
        const void* x0 = XSRC == 0 ? (const void*)(m0 < MTP ? xp + (size_t)m0 * D : xs + (size_t)(m0 - MTP) * D) : (const void*)(XB + (size_t)m0 * D);
        row_load<XSRC == 0, true>(v0, q0, x0, MMb + (size_t)m0 * D, m0 >= MTP ? PB + (size_t)(m0 - MTP) * D : nullptr, ns, lane);
        if (has1) { const void* x1 = XSRC == 0 ? (const void*)(m1 < MTP ? xp + (size_t)m1 * D : xs + (size_t)(m1 - MTP) * D) : (const void*)(XB + (size_t)m1 * D);
            row_load<XSRC == 0, true>(v1, q1, x1, MMb + (size_t)m1 * D, m1 >= MTP ? PB + (size_t)(m1 - MTP) * D : nullptr, ns, lane); }
        row_finish<true, OUT_F32, WANT_RSTD>(v0, q0, g, OUT_F32 ? (void*)(outf + (size_t)m0 * D) : (void*)(XB + (size_t)m0 * D), RSTD + m0, lane);
        if (has1) row_finish<true, OUT_F32, WANT_RSTD>(v1, q1, g, OUT_F32 ? (void*)(outf + (size_t)m1 * D) : (void*)(XB + (size_t)m1 * D), RSTD + m1, lane);
    }
}

template <int XSRC, bool OUT_F32, bool WANT_RSTD> __device__ __forceinline__ void sample_rowop_after_gemm(const Ctx& C, const pg8::SchedTail& S, unsigned* cnt, const float* xs, bf16_t* XB, const bf16_t* PB, const float* g1, float* outf, float* RSTD) {
    const int c = S.c, NSh = S.NS >> 1, yy = (c >> 3) & 7;
    if (c >= 256 || yy < NSh) return;
    const int q = (c & 7) + 8 * ((yy - NSh) + (8 - NSh) * (c >> 6));
    if (q >= 16 * S.NS) return;
    f32x4 g[4];
#pragma unroll
    for (int j = 0; j < 4; ++j) g[j] = *(const f32x4*)(g1 + 8 * C.lane + 512 * (j >> 1) + 4 * (j & 1));
    {
        const int ks = q % S.NS, t = q / S.NS, pmq = 64 + (t >> 2), pnq = t & 3;
        const unsigned target = 4u * (unsigned)S.NS; const int nrows = 256 / (4 * S.NS), r0 = pmq * 256 + (pnq * S.NS + ks) * nrows;
        if (C.tid == 0) { unsigned sp = 0;
            while (__hip_atomic_load(cnt + 64 * (pmq - 64), __ATOMIC_RELAXED, __HIP_MEMORY_SCOPE_AGENT) < target) { __builtin_amdgcn_s_sleep(2); if (++sp > (1u << 22)) break; }
            __builtin_amdgcn_fence(__ATOMIC_ACQUIRE, "agent"); asm volatile("s_waitcnt vmcnt(0)" ::: "memory"); }
        __syncthreads();
        for (int k = C.wave; k < nrows; k += 8) {
            const int m0 = r0 + k; f32x4 v0[4], q0[4];
            const void* x0 = XSRC == 0 ? (const void*)(xs + (size_t)(m0 - MTP) * D) : (const void*)(XB + (size_t)m0 * D);
            row_load<XSRC == 0, true>(v0, q0, x0, nullptr, PB + (size_t)(m0 - MTP) * D, S.NS, C.lane);
            row_finish<true, OUT_F32, WANT_RSTD ? 2 : 0>(v0, q0, g, OUT_F32 ? (void*)(outf + (size_t)m0 * D) : (void*)(XB + (size_t)m0 * D), RSTD + (size_t)m0 * 4, C.lane);
        }
    }
}

template <int STAGE> __device__ __forceinline__ void p0_stage(const Ctx& C, const Args& A, int widx, int nw) {
    LAS float* scr = (LAS float*)(C.lds + C.wave * 16384);
    const int gw = widx * NWAVES + C.wave, NGW = nw * NWAVES;
    unsigned char* ws = C.ws; unsigned char* ob = (unsigned char*)C.out;
    constexpr int I_G1 = 16 * 192, I_G3 = 48 * 32, I_F1 = 16 * 176, I_F2 = 44 * 32, I_R1 = 16 * 64, I_R2 = 16 * 32, I_AX = 8;
    if constexpr (STAGE == 0) {
        for (int it = gw; it < I_G1; it += NGW) p0_transpose_item<0>(A.in[5], 1024, 6144, (bf16_t*)(ob + DO_WG1), 0, scr, it, C.lane, A.in[4] + 0 * D);
        for (int m = gw; m < MT; m += NGW) {
            const float* xr = m < MTP ? A.in[0] + (size_t)m * D : A.in[1] + (size_t)(m - MTP) * D;
            row_op<true, false, false, true>(xr, nullptr, nullptr, 0, nullptr, (bf16_t*)(ob + DO_HN) + (size_t)m * D, (float*)(ws + WS_RSTD) + m, C.lane);
        }
    }
    if constexpr (STAGE == 1) {
        constexpr int NITEMS = I_G3 + I_F1 + I_F2 + I_R1 + 16 * I_AX;
        for (int it = gw; it < NITEMS; it += NGW) {
            int r = it;
            if (r < I_G3) { p0_transpose_item<0>(A.in[11], 3072, 1024, (bf16_t*)(ws + WS_WG3), 0, scr, r, C.lane); continue; } r -= I_G3;
            if (r < I_F1) { p0_transpose_item<1>(A.in[21], 1024, 5632, (bf16_t*)(ws + WS_WF1), 0, scr, r, C.lane, A.in[4] + 2 * D); continue; } r -= I_F1;
            if (r < I_F2) { p0_transpose_item<0>(A.in[22], 2816, 1024, (bf16_t*)(ws + WS_WF2), 0, scr, r, C.lane); continue; } r -= I_F2;
            if (r < I_R1) { p0_transpose_item<0>(A.in[12], 1024, 2048, (bf16_t*)(ws + WS_WR1), 0, scr, r, C.lane, A.in[4] + 4 * D); continue; } r -= I_R1;
            { const int hg = r / I_AX, h = hg >> 1, gate = hg & 1;
              p0_transpose_item<0>((gate ? A.in[17] : A.in[15]) + (size_t)h * 16384, 128, 128, (bf16_t*)(ws + WS_WAX) + (size_t)h * 256 * 128, gate * 128, scr, r % I_AX, C.lane); }
        }
        const int gt = widx * NTHR + C.tid, NGT = nw * NTHR;
        for (int i = gt; i < 8 * 128 * 128; i += NGT) { const int t = (i >> 7) & 127, sx = i & 127; ((bf16_t*)(ws + WS_WSB))[i] = (bf16_t)f2bf(sx <= t ? A.in[9][i] : 0.f); }
        for (int i = gt; i < 1024; i += NGT) { const float l = A.in[19][i]; ((float*)(ws + WS_SP))[i] = (l < 0.f ? -l : 0.f) + log1pf(expf(-fabsf(l))); }
    }
    if constexpr (STAGE == 2) {
        constexpr int NITEMS = I_R2 + I_F1 + I_F2;
        for (int it = gw; it < NITEMS; it += NGW) {
            int r = it;
            if (r < I_R2) { p0_transpose_item<0>(A.in[20], 1024, 1024, (bf16_t*)(ws + WS_WR2), 0, scr, r, C.lane); continue; } r -= I_R2;
            if (r < I_F1) { p0_transpose_item<1>(A.in[21] + (size_t)1024 * 5632, 1024, 5632, (bf16_t*)(ws + WS_WF1B), 0, scr, r, C.lane, A.in[4] + 6 * D); continue; } r -= I_F1;
            p0_transpose_item<0>(A.in[22] + (size_t)2816 * 1024, 2816, 1024, (bf16_t*)(ws + WS_WF2B), 0, scr, r, C.lane);
        }
    }
}
template <int STAGE> __device__ __forceinline__ void p0_in_tail(const Ctx& C, const Args& A, int nunits, int bx) {
    const int nbusy = nunits % C.G;
    if (nbusy == 0) p0_stage<STAGE>(C, A, C.vcu, C.G);
    else if (bx >= nbusy) p0_stage<STAGE>(C, A, bx - nbusy, C.G - nbusy);
}

__device__ __forceinline__ void spatial_stats(const Ctx& C, int tok0, LAS float* RS, LAS float* MUR) {
    if (C.tid < 128) { const f32x2* ST = (const f32x2*)(C.ws + WS_ST); float s = 0.f, q = 0.f;
#pragma unroll 8
        for (int p = 0; p < 24; ++p) { const f32x2 v = ST[(size_t)p * MT + tok0 + C.tid]; s += v.x; q += v.y; }
        const float mean = s * (1.f / DG), var = q * (1.f / DG) - mean * mean, rstd = __builtin_amdgcn_rsqf(var + EPS);
        RS[C.tid] = rstd; MUR[C.tid] = mean * rstd; }
}
template <bool DRY> __device__ __forceinline__ void spatial_phase(const Ctx& C, const Args& A) {
    LAS unsigned char* lds = C.lds;
    LAS float* RS = (LAS float*)(lds + 34816); LAS float* MUR = (LAS float*)(lds + 36864);
    const int fr = C.lane & 15, fq = C.lane >> 4;
    bf16_t* U = (bf16_t*)(C.ws + WS_U); const bf16_t* VT = (const bf16_t*)(C.ws + WS_V); const bf16_t* WSB = (const bf16_t*)(C.ws + WS_WSB);
    const float* ln_g = A.in[7]; const float* ln_b = A.in[8]; const float* b_s = A.in[10]; const float* w_s = A.in[9];
    const f32x2* ST = (const f32x2*)(C.ws + WS_ST);
    for (int base = C.vcu; base < 1024; base += 4 * C.G) {
        const int g = base & 7;
        __syncthreads();
        { const int i = C.tid >> 7, t = C.tid & 127, id = base + C.G * i;
          if (id < 1024) { const int tok = (id >> 3) * 128 + t; float sm = 0.f, q = 0.f;
#pragma unroll 8
            for (int p = 0; p < 24; ++p) { const f32x2 v = ST[(size_t)p * MT + tok]; sm += v.x; q += v.y; }
            const float mean = sm * (1.f / DG), var = q * (1.f / DG) - mean * mean, rstd = __builtin_amdgcn_rsqf(var + EPS);
            RS[C.tid] = rstd; MUR[C.tid] = mean * rstd; } }
#pragma unroll
        for (int i = 0; i < 4; ++i) { const int p = C.tid + 512 * i, row = p >> 4, c16 = p & 15;
            const u32x4 w = *(const u32x4*)(WSB + (size_t)g * 16384 + row * 128 + c16 * 8); *(LAS u32x4*)(lds + row * 272 + c16 * 16) = w; }
        __syncthreads();
        float bsv[8];
#pragma unroll
        for (int m = 0; m < 8; ++m) bsv[m] = b_s[g * 128 + 16 * m + fr];
        u32x4 rB[3][4]; u32x2 rU[3][8]; float rG[3], rBn[3];
#define SP_ISSUE(s_) do { const int i_ = (s_) / 3, j_ = (s_) % 3, sl_ = (s_) % 3, id_ = base + C.G * i_; if (id_ < 1024) { const int tok0_ = (id_ >> 3) * 128, chb_ = g * 384 + 48 * C.wave + 16 * j_; \
            rG[sl_] = ln_g[chb_ + fr]; rBn[sl_] = ln_b[chb_ + fr]; \
            _Pragma("unroll") for (int kk = 0; kk < 4; ++kk) rB[sl_][kk] = *(const u32x4*)(VT + (size_t)(chb_ + fr) * MT + tok0_ + 32 * kk + 8 * fq); \
            _Pragma("unroll") for (int m = 0; m < 8; ++m) rU[sl_][m] = *(const u32x2*)(U + (size_t)(tok0_ + 16 * m + fr) * DG + chb_ + 4 * fq); } } while (0)
        SP_ISSUE(0); SP_ISSUE(1);
#pragma unroll
        for (int s = 0; s < 12; ++s) {
            if (s + 2 < 12) SP_ISSUE(s + 2);
            const int i = s / 3, j = s % 3, sl = s % 3, id = base + C.G * i;
            if (id < 1024) {
                const int tok0 = (id >> 3) * 128, chb = g * 384 + 48 * C.wave + 16 * j;
                const float Gc = rG[sl], Bc = rBn[sl];
                bf16x8 bfrag[4];
#pragma unroll
                for (int kk = 0; kk < 4; ++kk) {
                    const u32x4 raw = rB[sl][kk];
                    const LAS float* rp = RS + i * 128 + 32 * kk + 8 * fq; const LAS float* mp = MUR + i * 128 + 32 * kk + 8 * fq;
                    const f32x4 r0 = *(const LAS f32x4*)rp, r1 = *(const LAS f32x4*)(rp + 4), m0 = *(const LAS f32x4*)mp, m1 = *(const LAS f32x4*)(mp + 4);
                    const f32x4 vlo = (f32x4){bflo(raw.x), bfhi(raw.x), bflo(raw.y), bfhi(raw.y)}, vhi = (f32x4){bflo(raw.z), bfhi(raw.z), bflo(raw.w), bfhi(raw.w)};
                    const f32x4 o0 = vlo * (r0 * Gc) + (Bc - m0 * Gc), o1 = vhi * (r1 * Gc) + (Bc - m1 * Gc);
                    u32x4 w; w.x = pg8::cvt_pk_bf16(o0.x, o0.y); w.y = pg8::cvt_pk_bf16(o0.z, o0.w); w.z = pg8::cvt_pk_bf16(o1.x, o1.y); w.w = pg8::cvt_pk_bf16(o1.z, o1.w);
                    bfrag[kk] = __builtin_bit_cast(bf16x8, w);
                }
#pragma unroll
                for (int m = 0; m < 8; ++m) { f32x4 acc = (f32x4){0.f, 0.f, 0.f, 0.f};
#pragma unroll
                    for (int kk = 0; kk < 4; ++kk) if (kk <= (m >> 1)) {
                        const bf16x8 af = *(const LAS bf16x8*)(lds + (16 * m + fr) * 272 + (32 * kk + 8 * fq) * 2);
                        acc = __builtin_amdgcn_mfma_f32_16x16x32_bf16(bfrag[kk], af, acc, 0, 0, 0); }
                    const float bs = bsv[m]; const u32x2 uw = rU[sl][m];
                    u32x2 o; o.x = pg8::cvt_pk_bf16(bflo(uw.x) * (acc[0] + bs), bfhi(uw.x) * (acc[1] + bs)); o.y = pg8::cvt_pk_bf16(bflo(uw.y) * (acc[2] + bs), bfhi(uw.y) * (acc[3] + bs));
                    *(u32x2*)(U + (size_t)(tok0 + 16 * m + fr) * DG + chb + 4 * fq) = o; }
            }
        }
#undef SP_ISSUE
    }
    for (int r = C.vcu; r < 256; r += C.G) {
        const int sc = r >> 5, g = (r >> 2) & 7, quarter = r & 3, tok0 = MTP + sc * 128;
        __syncthreads();
        if (C.tid < 128) { float sm = 0.f, q = 0.f;
#pragma unroll 8
            for (int p = 0; p < 24; ++p) { const f32x2 v = ST[(size_t)p * MT + tok0 + C.tid]; sm += v.x; q += v.y; }
            const float mean = sm * (1.f / DG), var = q * (1.f / DG) - mean * mean, rstd = __builtin_amdgcn_rsqf(var + EPS);
            RS[C.tid] = rstd; MUR[C.tid] = mean * rstd; }
        __syncthreads();
        float* OV = C.out + O_SV;
#pragma unroll
        for (int p4 = 0; p4 < 3; ++p4) { const int p = C.tid + NTHR * p4;
            const int dbl = p / 96, cl = p - dbl * 96, ch = g * 384 + quarter * 96 + cl, db = sc * 16 + dbl;
            const float Gc = ln_g[ch], Bc = ln_b[ch];
            const u32x4 raw = *(const u32x4*)(VT + (size_t)ch * MT + MTP + db * 8);
            float vn[8]; const float vv[8] = {bflo(raw.x), bfhi(raw.x), bflo(raw.y), bfhi(raw.y), bflo(raw.z), bfhi(raw.z), bflo(raw.w), bfhi(raw.w)};
#pragma unroll
            for (int sx = 0; sx < 8; ++sx) { vn[sx] = vv[sx] * (RS[dbl * 8 + sx] * Gc) + (Bc - MUR[dbl * 8 + sx] * Gc); OV[(size_t)(db * 8 + sx) * DG + ch] = vn[sx]; }
#pragma unroll
            for (int t = 0; t < 8; ++t) { float mx = b_s[g * 128 + t];
#pragma unroll
                for (int sx = 0; sx <= t; ++sx) mx += w_s[g * 16384 + t * 128 + sx] * vn[sx];
                bf16_t* up = U + (size_t)(MTP + db * 8 + t) * DG + ch; *up = (bf16_t)f2bf(bflo((unsigned)*up) * mx); }
        }
    }
    __syncthreads();
}

constexpr int RG_TILE = 64, RG_NT = MT / RG_TILE  , RG_NTP = MTP / RG_TILE  , RG_PITCH = 132;
__device__ __forceinline__ float one_minus_exp(float x, float ex  ) {
    float p = x * (1.f / 5040.f) + (1.f / 720.f); p = p * x + (1.f / 120.f); p = p * x + (1.f / 24.f); p = p * x + (1.f / 6.f); p = p * x + 0.5f; p = p * x + 1.0f; p = -(p * x);
    const float e = 1.0f - ex;
    return x > -0.3f ? p : e;
}
__device__ __forceinline__ void rg_phase1(const Ctx& C, const Args& A) {
    LAS unsigned char* lds = C.lds;
    LAS float* XC = (LAS float*)(lds + 69632); LAS float* BB = XC; LAS float* AA = (LAS float*)(lds + 103424); LAS f32x2* SUM = (LAS f32x2*)(lds + 137216);
    const int fr = C.lane & 15, fq = C.lane >> 4, h = C.vcu & 7;
    const bf16_t* XBR = (const bf16_t*)(C.ws + WS_U) + (size_t)MT * D; const bf16_t* WAX = (const bf16_t*)(C.ws + WS_WAX); const float* SP = (const float*)(C.ws + WS_SP);
    bf16_t* GATE = (bf16_t*)(C.ws + WS_U); f32x2* TS = (f32x2*)(C.ws + WS_TS); unsigned* FLG = (unsigned*)(C.ws + WS_FLG); LAS float* CARRY = (LAS float*)(lds + 137216 + 4096);
    const float* conv_w = A.in[13]; const float* conv_b = A.in[14]; const float* b_a = A.in[16]; const float* b_x = A.in[18]; const float* st_conv = A.in[2]; const float* st_h = A.in[3];
#pragma unroll
    for (int i = 0; i < 8; ++i) { const int p = C.tid + 512 * i, row = p >> 4, c16 = p & 15; *(LAS u32x4*)(lds + row * 272 + c16 * 16) = *(const u32x4*)(WAX + ((size_t)h * 256 + row) * 128 + c16 * 8); }
    const int cg8 = C.tid & 15, tr = C.tid >> 4, c8 = h * 128 + cg8 * 8;
    f32x4 w[4][2], bb[2];
#pragma unroll
    for (int k = 0; k < 4; ++k) { w[k][0] = *(const f32x4*)(conv_w + k * 1024 + c8); w[k][1] = *(const f32x4*)(conv_w + k * 1024 + c8 + 4); }
    bb[0] = *(const f32x4*)(conv_b + c8); bb[1] = *(const f32x4*)(conv_b + c8 + 4);
    const int mb = C.wave & 3, nh = C.wave >> 2;
    LAS float* HC = (LAS float*)(lds + 141824);
    if (C.tid < 128) { HC[C.tid] = b_a[h * 128 + C.tid]; HC[128 + C.tid] = b_x[h * 128 + C.tid]; HC[256 + C.tid] = SP[h * 128 + C.tid]; }
    u32x4 pre[2][4];
#define RG_LOADROWS(tile_) do { const int tok0_ = (tile_) * RG_TILE; const bool smp_ = (tile_) >= RG_NTP; \
        _Pragma("unroll") for (int i = 0; i < 2; ++i) { const int tok_ = tok0_ + tr + 32 * i, tl_ = smp_ ? ((tok_ - MTP) & 7) : (tok_ & (SEQ - 1)); \
            _Pragma("unroll") for (int k = 0; k < 4; ++k) { pre[i][k] = (u32x4){0u, 0u, 0u, 0u}; if (tl_ + k - 3 >= 0) pre[i][k] = *(const u32x4*)(XBR + (size_t)(tok_ + k - 3) * D + c8); } } } while (0)
    if (C.vcu < RG_NT * 8) RG_LOADROWS(C.vcu >> 3);
    __syncthreads();
    for (int id = C.vcu; id < RG_NT * 8; id += C.G) {
        const int tile = id >> 3, tok0 = tile * RG_TILE; const bool sample = tile >= RG_NTP;
        {
#pragma unroll
            for (int i = 0; i < 2; ++i) { const int t = tr + 32 * i, tok = tok0 + t;
                const int L = sample ? 8 : SEQ, tl = sample ? ((tok - MTP) & 7) : (tok & (SEQ - 1)), sq = sample ? ((tok - MTP) >> 3) : (tok >> 11);
                f32x4 x0 = bb[0], x1 = bb[1];
#pragma unroll
                for (int k = 0; k < 4; ++k) { const u32x4 raw = pre[i][k];
                    f32x4 r0 = (f32x4){bflo(raw.x), bfhi(raw.x), bflo(raw.y), bfhi(raw.y)}, r1 = (f32x4){bflo(raw.z), bfhi(raw.z), bflo(raw.w), bfhi(raw.w)};
                    if (sample && tl + k - 3 < 0) { const float* hp = st_conv + (size_t)(sq * 3 + (tl + k)) * D + c8; r0 = *(const f32x4*)hp; r1 = *(const f32x4*)(hp + 4); }
                    x0 = x0 + w[k][0] * r0; x1 = x1 + w[k][1] * r1;
                    if (k == 3 && tl >= L - 3) { float* op = C.out + (sample ? O_SCONV : O_PCONV) + (size_t)(sq * 3 + (tl - (L - 3))) * D + c8; *(f32x4*)op = r0; *(f32x4*)(op + 4) = r1; } }
                *(LAS f32x4*)(XC + t * RG_PITCH + cg8 * 8) = x0; *(LAS f32x4*)(XC + t * RG_PITCH + cg8 * 8 + 4) = x1; }
        }
        __syncthreads();
        bf16x8 af[4]; f32x4 xc4[4];
        {
#pragma unroll
            for (int kk = 0; kk < 4; ++kk) { const LAS float* xp = XC + (16 * mb + fr) * RG_PITCH + 32 * kk + 8 * fq; const f32x4 a0 = *(const LAS f32x4*)xp, a1 = *(const LAS f32x4*)(xp + 4);
                u32x4 wv; wv.x = pg8::cvt_pk_bf16(a0.x, a0.y); wv.y = pg8::cvt_pk_bf16(a0.z, a0.w); wv.z = pg8::cvt_pk_bf16(a1.x, a1.y); wv.w = pg8::cvt_pk_bf16(a1.z, a1.w); af[kk] = __builtin_bit_cast(bf16x8, wv); }
#pragma unroll
            for (int nb = 0; nb < 4; ++nb) xc4[nb] = *(const LAS f32x4*)(XC + (16 * mb + fr) * RG_PITCH + 64 * nh + 16 * nb + 4 * fq);
        }
        __syncthreads();
        if (id + C.G < RG_NT * 8) RG_LOADROWS((id + C.G) >> 3);
        u32x4 gpre[2];
#pragma unroll
        for (int i = 0; i < 2; ++i) { const int p = C.tid + 512 * i; gpre[i] = *(const u32x4*)(GATE + (size_t)(tok0 + (p >> 4)) * D + h * 128 + (p & 15) * 8); }
        {
#pragma unroll
            for (int nb = 0; nb < 4; ++nb) {
                f32x4 ra = (f32x4){0.f, 0.f, 0.f, 0.f}, ia = ra;
                const LAS unsigned char* wp = lds + (64 * nh + 16 * nb + fr) * 272 + 16 * fq;
#pragma unroll
                for (int kk = 0; kk < 4; ++kk) { const bf16x8 ba = *(const LAS bf16x8*)(wp + 64 * kk), bx = *(const LAS bf16x8*)(wp + 128 * 272 + 64 * kk);
                    ra = __builtin_amdgcn_mfma_f32_16x16x32_bf16(ba, af[kk], ra, 0, 0, 0); ia = __builtin_amdgcn_mfma_f32_16x16x32_bf16(bx, af[kk], ia, 0, 0, 0); }
                const int t = 16 * mb + fr, cl = 64 * nh + 16 * nb + 4 * fq;
                f32x4 av, bv; const f32x4 bav = *(const LAS f32x4*)(HC + cl), bxv = *(const LAS f32x4*)(HC + 128 + cl), spv = *(const LAS f32x4*)(HC + 256 + cl);
#pragma unroll
                for (int j = 0; j < 4; j += 2) {
                    const f32x2 zr = ((f32x2){ra[j], ra[j + 1]} + (f32x2){bav[j], bav[j + 1]}) * -1.4426950409f, zi = ((f32x2){ia[j], ia[j + 1]} + (f32x2){bxv[j], bxv[j + 1]}) * -1.4426950409f;
                    f32x2 er, ei; er.x = __builtin_amdgcn_exp2f(zr.x); er.y = __builtin_amdgcn_exp2f(zr.y); ei.x = __builtin_amdgcn_exp2f(zi.x); ei.y = __builtin_amdgcn_exp2f(zi.y);
                    const f32x2 dr = er + 1.0f, di = ei + 1.0f; f32x2 r, ii; r.x = __builtin_amdgcn_rcpf(dr.x); r.y = __builtin_amdgcn_rcpf(dr.y); ii.x = __builtin_amdgcn_rcpf(di.x); ii.y = __builtin_amdgcn_rcpf(di.y);
                    const f32x2 la = r * (f32x2){spv[j], spv[j + 1]} * -8.0f, le = la * 1.4426950409f; f32x2 a; a.x = __builtin_amdgcn_exp2f(le.x); a.y = __builtin_amdgcn_exp2f(le.y);
                    const f32x2 x2 = la * 2.0f;
                    f32x2 p = x2 * (1.f / 5040.f) + (1.f / 720.f); p = p * x2 + (1.f / 120.f); p = p * x2 + (1.f / 24.f); p = p * x2 + (1.f / 6.f); p = p * x2 + 0.5f; p = p * x2 + 1.0f; p = -(p * x2);
                    const f32x2 e = 1.0f - a * a; f32x2 om; om.x = x2.x > -0.3f ? p.x : e.x; om.y = x2.y > -0.3f ? p.y : e.y;
                    f32x2 sq; sq.x = __builtin_amdgcn_sqrtf(om.x); sq.y = __builtin_amdgcn_sqrtf(om.y);
                    const f32x2 b2 = sq * (ii * (f32x2){xc4[nb][j], xc4[nb][j + 1]});
                    av[j] = a.x; av[j + 1] = a.y; bv[j] = b2.x; bv[j + 1] = b2.y; }
                *(LAS f32x4*)(AA + t * RG_PITCH + cl) = av; *(LAS f32x4*)(BB + t * RG_PITCH + cl) = bv;
            }
        }
        __syncthreads();
        {
            const int chl = C.tid & 127, q = C.tid >> 7, ch = h * 128 + chl;
            if (!sample) {
                float Ap = 1.f, Bp = 0.f;
#pragma unroll 4
                for (int t = 16 * q; t < 16 * q + 16; ++t) { const float a = AA[t * RG_PITCH + chl], b = BB[t * RG_PITCH + chl]; Bp = a * Bp + b; Ap *= a; }
                SUM[q * 128 + chl] = (f32x2){Ap, Bp};
                __syncthreads();
                const int first = tile & ~31, nprev = tile & 31;
                if (C.tid < 128) { float At = 1.f, Bt = 0.f;
#pragma unroll
                    for (int qq = 0; qq < 4; ++qq) { const f32x2 sm = SUM[qq * 128 + chl]; Bt = sm.x * Bt + sm.y; At *= sm.x; }
                    __hip_atomic_store((unsigned long long*)(TS + (size_t)tile * D + ch), ((unsigned long long)__float_as_uint(Bt) << 32) | __float_as_uint(At), __ATOMIC_RELAXED, __HIP_MEMORY_SCOPE_AGENT); }
                asm volatile("s_waitcnt vmcnt(0)" ::: "memory");
                __syncthreads();
                if (C.tid == 0) __hip_atomic_store(FLG + (size_t)(tile * 8 + h) * 16, 1u, __ATOMIC_RELAXED, __HIP_MEMORY_SCOPE_AGENT);
                if (C.wave == 0) { unsigned sp = 0;
                    for (;;) { const unsigned f = C.lane < nprev ? __hip_atomic_load(FLG + (size_t)((first + C.lane) * 8 + h) * 16, __ATOMIC_RELAXED, __HIP_MEMORY_SCOPE_AGENT) : 1u;
                        if (__builtin_amdgcn_ballot_w64(f == 0u) == 0ull) break; __builtin_amdgcn_s_sleep(2); if (++sp > (1u << 22)) break; }
                    __builtin_amdgcn_fence(__ATOMIC_ACQUIRE, "agent"); }
                asm volatile("s_waitcnt vmcnt(0)" ::: "memory");
                __syncthreads();
                if (C.tid < 128) { float carry = 0.f;
#pragma unroll
                    for (int j0 = 0; j0 < 32; j0 += 16) { unsigned long long sv[16];
#pragma unroll
                        for (int j = 0; j < 16; ++j) sv[j] = (j0 + j < nprev) ? __hip_atomic_load((const unsigned long long*)(TS + (size_t)(first + j0 + j) * D + ch), __ATOMIC_RELAXED, __HIP_MEMORY_SCOPE_AGENT) : 0x000000003f800000ull;
#pragma unroll
                        for (int j = 0; j < 16; ++j) carry = __uint_as_float((unsigned)sv[j]) * carry + __uint_as_float((unsigned)(sv[j] >> 32)); }
                    CARRY[chl] = carry; }
                __syncthreads();
                float hv = CARRY[chl];
                for (int qq = 0; qq < q; ++qq) { const f32x2 sm = SUM[qq * 128 + chl]; hv = sm.x * hv + sm.y; }
#pragma unroll 4
                for (int t = 16 * q; t < 16 * q + 16; ++t) { hv = AA[t * RG_PITCH + chl] * hv + BB[t * RG_PITCH + chl]; AA[t * RG_PITCH + chl] = hv; }
                if (q == 3 && nprev == 31) C.out[O_PH + (size_t)(tile >> 5) * D + ch] = hv;
            } else {
#pragma unroll
                for (int s2 = 0; s2 < 2; ++s2) { const int db = ((tok0 - MTP) >> 3) + 2 * q + s2; float hv = st_h[(size_t)db * D + ch];
#pragma unroll
                    for (int t8 = 0; t8 < 8; ++t8) { const int t = 16 * q + 8 * s2 + t8; hv = AA[t * RG_PITCH + chl] * hv + BB[t * RG_PITCH + chl]; AA[t * RG_PITCH + chl] = hv; }
                    C.out[O_SH + (size_t)db * D + ch] = hv; }
            }
        }
        __syncthreads();
#pragma unroll
        for (int i = 0; i < 2; ++i) { const int p = C.tid + 512 * i, t = p >> 4, c8l = (p & 15) * 8;
            const f32x4 h0 = *(const LAS f32x4*)(AA + t * RG_PITCH + c8l), h1 = *(const LAS f32x4*)(AA + t * RG_PITCH + c8l + 4); const u32x4 gt = gpre[i];
            u32x4 o; o.x = pg8::cvt_pk_bf16(h0.x * bflo(gt.x), h0.y * bfhi(gt.x)); o.y = pg8::cvt_pk_bf16(h0.z * bflo(gt.y), h0.w * bfhi(gt.y)); o.z = pg8::cvt_pk_bf16(h1.x * bflo(gt.z), h1.y * bfhi(gt.z)); o.w = pg8::cvt_pk_bf16(h1.z * bflo(gt.w), h1.w * bfhi(gt.w));
            *(u32x4*)(GATE + (size_t)(tok0 + t) * D + h * 128 + c8l) = o; }
        __syncthreads();
    }
#undef RG_LOADROWS
}
template <bool DRY> __device__ __forceinline__ void rg_phase2(const Ctx& C) {
    LAS float* CARRY = (LAS float*)C.lds;
    bf16_t* GATE = (bf16_t*)(C.ws + WS_U); const bf16_t* HL = (const bf16_t*)(C.ws + WS_V); const bf16_t* CA = (const bf16_t*)(C.ws + WS_V + (size_t)MT * D * 4); const f32x2* TS = (const f32x2*)(C.ws + WS_TS);
    for (int id = C.vcu; id < RG_NT * 8; id += C.G) {
        const int tile = id >> 3, h = id & 7, tok0 = tile * RG_TILE; const bool sample = tile >= RG_NTP;
        if (C.tid < 128) { const int ch = h * 128 + C.tid; float carry = 0.f;
            if (!sample) { const int first = tile & ~31, nprev = tile & 31;
                f32x2 sv[31];
#pragma unroll
                for (int j = 0; j < 31; ++j) sv[j] = (j < nprev) ? TS[(size_t)(first + j) * D + ch] : (f32x2){1.f, 0.f};
#pragma unroll
                for (int j = 0; j < 31; ++j) carry = sv[j].x * carry + sv[j].y; }
            CARRY[C.tid] = carry; }
        __syncthreads();
#pragma unroll
        for (int i = 0; i < 2; ++i) { const int p = C.tid + 512 * i, t = p >> 4, cg8 = p & 15, tok = tok0 + t, c8 = h * 128 + cg8 * 8; const size_t off = (size_t)tok * D + c8;
            const u32x4 hlw = *(const u32x4*)(HL + off); const f32x4 h0 = (f32x4){bflo(hlw.x), bfhi(hlw.x), bflo(hlw.y), bfhi(hlw.y)}, h1 = (f32x4){bflo(hlw.z), bfhi(hlw.z), bflo(hlw.w), bfhi(hlw.w)}; const u32x4 ca = *(const u32x4*)(CA + off), gt = *(const u32x4*)(GATE + off);
            const f32x4 c0 = *(const LAS f32x4*)(CARRY + cg8 * 8), c1 = *(const LAS f32x4*)(CARRY + cg8 * 8 + 4);
            f32x4 v0 = h0, v1 = h1;
            if (!sample) { v0 = v0 + (f32x4){bflo(ca.x), bfhi(ca.x), bflo(ca.y), bfhi(ca.y)} * c0; v1 = v1 + (f32x4){bflo(ca.z), bfhi(ca.z), bflo(ca.w), bfhi(ca.w)} * c1; }
            u32x4 o; o.x = pk2(v0.x * bflo(gt.x), v0.y * bfhi(gt.x)); o.y = pk2(v0.z * bflo(gt.y), v0.w * bfhi(gt.y)); o.z = pk2(v1.x * bflo(gt.z), v1.y * bfhi(gt.z)); o.w = pk2(v1.z * bflo(gt.w), v1.w * bfhi(gt.w));
            *(u32x4*)((DRY ? GATE + (size_t)2 * MT * D : GATE) + off) = o;
            if (!sample && (tok & (SEQ - 1)) == SEQ - 1) { float* op = C.out + O_PH + (size_t)(tok >> 11) * D + c8; *(f32x4*)op = v0; *(f32x4*)(op + 4) = v1; } }
        __syncthreads();
    }
}

template <int K, bool DRY = false> __device__ __forceinline__ void run_phase(const Ctx& C, const Args& args) {
    unsigned char* ws = args.ws; unsigned char* ob = (unsigned char*)args.out;
    bf16_t* const Ubuf = (bf16_t*)(ws + WS_U); bf16_t* const Vbuf = (bf16_t*)(ws + WS_V);
    bf16_t* const MMb = Vbuf;
    bf16_t* const HNb = Vbuf + (size_t)MT * D;
    bf16_t* const PB = (bf16_t*)(ws + WS_V + 68 * MiB);
    constexpr int NS_G3 = 8, NS_F2 = 8, NS_G9 = 4;
    const int gw = C.vcu * NWAVES + C.wave, NGW = C.G * NWAVES;
    const float* gains = args.in[4]; float* const RSTD = (float*)(ws + WS_RSTD);
    unsigned* const ECNT = (unsigned*)(ws + WS_CNT); unsigned* const SCNT = ECNT + 4 * 2 * 64 * 64;
    float* const XS1 = (float*)(ws + WS_ST); float* const RS16 = (float*)(ws + WS_ST + 2560 * 1024);
    const int bx = (int)blockIdx.x;

    if constexpr (K == 0) { p0_stage<0>(C, args, C.vcu, C.G); }
    if constexpr (K == 1) {
        const bf16_t* hn0 = (const bf16_t*)(ob + DO_HN); const bf16_t* wg1 = (const bf16_t*)(ob + DO_WG1);
        pg8::Sched S; S.init(hn0, wg1, MT, DG, wg1 + (size_t)DG * D, hn0, DG, MT, D, C.G, bx);
        pg8::EpiG1 E{Ubuf, Vbuf, args.in[6], (f32x2*)(ws + WS_ST), RSTD};
        pg8::gemm_phase(C.lds, D, S, E);
        if (!DRY) p0_in_tail<1>(C, args, 68 * 24, bx);
    }
    if constexpr (K == 2) { spatial_phase<DRY>(C, args); }
    if constexpr (K == 3) {
        pg8::SchedTail S; S.init(Ubuf, ws + WS_WG3, DG, NS_G3, C.G, bx);
        pg8::RmsExchange e1{XS1, ECNT + (0 * 2 + 0) * 4096};
        pg8::EpiTailFused<false> E{PB, SCNT + 0 * 256, e1, (const bf16_t*)(ob + DO_HN), HNb, gains + 1 * D, nullptr, RS16, C.lds + 131072};   pg8::gemm_phase(C.lds, DG, S, E);
        sample_rowop_after_gemm<0, false, true>(C, S, SCNT + 0 * 256, args.in[1], HNb, PB, gains + 1 * D, nullptr, RS16);
    }
    if constexpr (K == 4) {
    }
    if constexpr (K == 5) {
        pg8::Sched S; S.init(HNb, ws + WS_WF1, MT, 2 * DFF, nullptr, nullptr, 0, 0, D, C.G, bx);
        pg8::EpiSwiglu E{Ubuf, RS16}; pg8::gemm_phase(C.lds, D, S, E);
    }
    if constexpr (K == 6) {
        pg8::SchedTail S; S.init(Ubuf, ws + WS_WF2, DFF, NS_F2, C.G, bx);
        pg8::RmsExchange e1{XS1, ECNT + (1 * 2 + 0) * 4096};
        pg8::EpiTailFused<false> E{PB, SCNT + 1 * 256, e1, HNb, HNb, gains + 3 * D, nullptr, RS16, C.lds + 131072}; pg8::gemm_phase(C.lds, DFF, S, E);
        sample_rowop_after_gemm<1, false, true>(C, S, SCNT + 1 * 256, nullptr, HNb, PB, gains + 3 * D, nullptr, RS16);
    }
    if constexpr (K == 7) {
    }
    if constexpr (K == 8) {
        pg8::Sched S; S.init(HNb, ws + WS_WR1, MT, 2 * D, nullptr, nullptr, 0, 0, D, C.G, bx);
        pg8::EpiG6 E{Ubuf, Ubuf + (size_t)MT * D, RS16}; pg8::gemm_phase(C.lds, D, S, E);
        if (!DRY) p0_in_tail<2>(C, args, 68 * 8, bx);
    }
    if constexpr (K == 9) { rg_phase1(C, args); }
    if constexpr (K == 11) {
        pg8::SchedTail S; S.init(Ubuf, ws + WS_WR2, D, NS_G9, C.G, bx);
        pg8::RmsExchange e1{XS1, ECNT + (2 * 2 + 0) * 4096};
        pg8::EpiTailFused<false> E{PB, SCNT + 2 * 256, e1, HNb, HNb, gains + 5 * D, nullptr, RS16, C.lds + 131072}; pg8::gemm_phase(C.lds, D, S, E);
        sample_rowop_after_gemm<1, false, true>(C, S, SCNT + 2 * 256, nullptr, HNb, PB, gains + 5 * D, nullptr, RS16);
    }
    if constexpr (K == 12) {
    }
    if constexpr (K == 13) {
        pg8::Sched S; S.init(HNb, ws + WS_WF1B, MT, 2 * DFF, nullptr, nullptr, 0, 0, D, C.G, bx);
        pg8::EpiSwiglu E{Ubuf, RS16}; pg8::gemm_phase(C.lds, D, S, E);
    }
    if constexpr (K == 14) {
        pg8::SchedTail S; S.init(Ubuf, ws + WS_WF2B, DFF, NS_F2, C.G, bx);
        pg8::RmsExchange e1{XS1, ECNT + (3 * 2 + 0) * 4096};
        pg8::EpiTailFused<true> E{PB, SCNT + 3 * 256, e1, HNb, HNb, gains + 7 * D, args.out, RS16, C.lds + 131072}; pg8::gemm_phase(C.lds, DFF, S, E);
        sample_rowop_after_gemm<1, true, false>(C, S, SCNT + 3 * 256, nullptr, HNb, PB, gains + 7 * D, args.out, RS16);
    }
    if constexpr (K == 15) {
    }
}
constexpr int NPH = 16;
__global__ void __launch_bounds__(NTHR, 2) fwd_kernel(Args args) {
    extern __shared__ __attribute__((aligned(16))) unsigned char lds_raw[];
    Ctx C; C.lds = (LAS unsigned char*)lds_raw; C.tid = threadIdx.x; C.lane = C.tid & 63; C.wave = __builtin_amdgcn_readfirstlane(C.tid >> 6);
    C.G = gridDim.x; { const int bx = blockIdx.x; C.vcu = (C.G % 8 == 0) ? (bx % 8) * (C.G / 8) + bx / 8 : bx; }
    C.out = args.out; C.ws = args.ws;
    for (int u = C.tid; u < 64; u += NTHR) ((LAS unsigned*)(C.lds + LDS_BYTES - 256))[u] = 0u;
    __syncthreads();
    const XcdBarrier bar = xcd_barrier_post((unsigned*)(args.ws + WS_BAR), (volatile LAS unsigned*)(C.lds + LDS_BYTES - 256 + 32));
    const int lo = args.ph_lo, hi = args.ph_hi;
#ifndef REP_MASK
#define REP_MASK 0
#endif
#ifndef XSYNC
#define XSYNC 0
#endif
#define REPS(k) (((REP_MASK >> (k)) & 1) ? 2 : 1)
#ifndef PH_MASK
#define PH_MASK 0xffff
#endif
#define IN(k) (((PH_MASK >> (k)) & 1) && lo <= (k) && (k) < hi)
#if MK_ONE_LAUNCH
#define SEAM(k) do { if ((k) != 3 && (k) != 6 && (k) != 9 && (k) != 11 && (k) != 14 && IN(k) && IN((k) + 1)) { xcd_barrier(bar); } } while (0)
#else
#define SEAM(k) do { } while (0)
#endif
    if (hi == 0x7fffffff) cg::this_grid().sync();
#define PHASE(k) do { if (IN(k)) { if (REPS(k) == 2) run_phase<k, true>(C, args); run_phase<k>(C, args); } SEAM(k); } while (0)
    PHASE(0);
    for (int xs_ = 0; xs_ < XSYNC; ++xs_) cg::this_grid().sync();
    PHASE(1); PHASE(2); PHASE(3); PHASE(4); PHASE(5); PHASE(6); PHASE(7); PHASE(8); PHASE(9); PHASE(10); PHASE(11); PHASE(12); PHASE(13); PHASE(14); PHASE(15);
#undef PHASE
#undef IN
#undef SEAM
}

extern "C" void kernel_launch(void* const* d_in, const int* in_sizes, int n_in, void* d_out, int out_size, void* d_ws, size_t ws_size, hipStream_t stream) {
    static int grid = 0;
    if (grid == 0) {
        int dev = 0, cus = 0, per_cu = 0;
        hipGetDevice(&dev); hipDeviceGetAttribute(&cus, hipDeviceAttributeMultiprocessorCount, dev);
        hipFuncSetAttribute((const void*)fwd_kernel, hipFuncAttributeMaxDynamicSharedMemorySize, LDS_BYTES);
        hipOccupancyMaxActiveBlocksPerMultiprocessor(&per_cu, (const void*)fwd_kernel, NTHR, LDS_BYTES);
        if (per_cu < 1) { fprintf(stderr, "kernel_launch: occupancy query says %d blocks/CU\n", per_cu); per_cu = 1; }
        (void)hipGetLastError();
        grid = cus * per_cu;
        if (n_in != 23 || ws_size < 256 * MiB) fprintf(stderr, "kernel_launch: unexpected n_in %d / ws %zu\n", n_in, ws_size);
    }
    (void)hipMemsetAsync((char*)d_ws + WS_BAR, 0, CTL_ZERO_BYTES, stream);
    Args a{};
    for (int i = 0; i < 23; ++i) a.in[i] = (const float*)d_in[i];
    a.out = (float*)d_out; a.ws = (unsigned char*)d_ws;
#if MK_ONE_LAUNCH
    a.ph_lo = 0; a.ph_hi = NPH;
    void* kargs[] = {&a};
    hipError_t e = hipLaunchCooperativeKernel((const void*)fwd_kernel, dim3(grid), dim3(NTHR), kargs, LDS_BYTES, stream);
    if (e != hipSuccess) fprintf(stderr, "cooperative launch failed: %s (grid %d)\n", hipGetErrorString(e), grid);
#else
    for (int p = 0; p < NPH; ++p) { a.ph_lo = p; a.ph_hi = p + 1; hipLaunchKernelGGL(fwd_kernel, dim3(grid), dim3(NTHR), LDS_BYTES, stream, a); }
#endif
}
```
